# Optimizing an MI355X kernel written in HIP

```python
import math
import jax
import jax.numpy as jnp
from jax import lax
import numpy as np

D_MODEL = 1024
BATCH = 16
SEQ = 256
DEPTH = 4
DEC_BATCH = 4
DEC_SEQ = 4096
PAST_LEN = 512

GRID_W = 64
EPS = 1e-6
A_WIDTH = 512
A_CONV = 3
SSM_INNER = 1024
SSM_HEAD_DIM = 64
SSM_HEADS = SSM_INNER // SSM_HEAD_DIM
SSM_GROUPS = 2
SSM_STATE = 128
SSM_CONV = 3
SSM_CONV_DIM = SSM_INNER + 2 * SSM_GROUPS * SSM_STATE
CHUNK = 128
MLA_HEADS = 8
Q_LORA = 256
KV_LORA = 256
NOPE_DIM = 64
ROPE_DIM = 32
V_DIM = 64
QK_DIM = NOPE_DIM + ROPE_DIM
ROPE_BASE = 10000.0
Q_BLOCK = 128
FF_DIM = -(-8 * D_MODEL // (3 * 256)) * 256
N_BRANCH = 3
IN_SIZES = (A_WIDTH, A_WIDTH, A_WIDTH,
            SSM_INNER, SSM_CONV_DIM, SSM_HEADS,
            Q_LORA, KV_LORA, ROPE_DIM,
            N_BRANCH * D_MODEL)
IN_COLS = sum(IN_SIZES)

kernel_name = 'hybrid_diffusion_parallel_conv_ssd_mla_step'


def rms_norm(x, w):
    xf = x.astype(jnp.float32)
    y = xf * lax.rsqrt(jnp.mean(xf * xf, axis=-1, keepdims=True) + EPS)
    return (y * w.astype(jnp.float32)).astype(x.dtype)


def split_columns(proj):
    outs, start = [], 0
    for size in IN_SIZES:
        outs.append(proj[..., start:start + size])
        start += size
    return outs


def conv3_centred(x, w):
    xp = jnp.pad(x, ((0, 0), (1, 1), (0, 0)))
    return xp[:, :-2] * w[0] + xp[:, 1:-1] * w[1] + xp[:, 2:] * w[2]


def axial_rope_tables(n_tokens):
    n_rows = n_tokens // GRID_W
    row = jnp.repeat(jnp.arange(n_rows, dtype=jnp.float32), GRID_W)
    col = jnp.tile(jnp.arange(GRID_W, dtype=jnp.float32), n_rows)
    pairs_per_axis = ROPE_DIM // 4
    inv = ROPE_BASE ** (-jnp.arange(pairs_per_axis, dtype=jnp.float32) / pairs_per_axis)
    ang = jnp.concatenate([row[:, None] * inv, col[:, None] * inv], axis=-1)
    return jnp.cos(ang), jnp.sin(ang)


def apply_rope(x, cos, sin):
    half = ROPE_DIM // 2
    x1, x2 = x[..., :half], x[..., half:]
    cos, sin = cos.astype(x.dtype), sin.astype(x.dtype)
    return jnp.concatenate([x1 * cos - x2 * sin, x1 * sin + x2 * cos], axis=-1)


def short_conv_branch(a_x, a_b, a_c, conv_w, w_out):
    return (a_b * conv3_centred(a_c * a_x, conv_w)) @ w_out


def ssd_chunked(x, dt, a, bmat, cmat, h0):
    bsz, seq = x.shape[:2]
    nc = seq // CHUNK
    hg = SSM_HEADS // SSM_GROUPS
    xg = x.reshape(bsz, nc, CHUNK, SSM_GROUPS, hg, SSM_HEAD_DIM)
    dtg = dt.reshape(bsz, nc, CHUNK, SSM_GROUPS, hg)
    bg = bmat.reshape(bsz, nc, CHUNK, SSM_GROUPS, SSM_STATE)
    cg = cmat.reshape(bsz, nc, CHUNK, SSM_GROUPS, SSM_STATE)
    cum = jnp.cumsum(dtg * a.reshape(SSM_GROUPS, hg), axis=2)
    seg = cum[:, :, :, None] - cum[:, :, None, :]
    lower = jnp.tril(jnp.ones((CHUNK, CHUNK), dtype=bool))[:, :, None, None]
    decay = jnp.exp(jnp.where(lower, seg, -jnp.inf))
    cb = jnp.einsum('bcign,bcjgn->bcijg', cg, bg)
    w_intra = decay * cb[..., None] * dtg[:, :, None]
    y_diag = jnp.einsum('bcijgh,bcjghp->bcighp', w_intra, xg)
    to_end = jnp.exp(cum[:, :, -1:] - cum) * dtg
    chunk_states = jnp.einsum('bcjgh,bcjgn,bcjghp->bcghpn', to_end, bg, xg)
    chunk_decay = jnp.exp(cum[:, :, -1])

    def step(h, inp):
        st, dec = inp
        return h * dec[..., None, None] + st, h

    h_init = h0.reshape(bsz, SSM_GROUPS, hg, SSM_HEAD_DIM, SSM_STATE)
    h_final, h_enter = lax.scan(step, h_init,
                                (jnp.moveaxis(chunk_states, 1, 0), jnp.moveaxis(chunk_decay, 1, 0)))
    h_enter = jnp.moveaxis(h_enter, 0, 1)
    y_off = jnp.einsum('bcign,bcghpn->bcighp', cg, h_enter) * jnp.exp(cum)[..., None]
    y = (y_diag + y_off).reshape(bsz, seq, SSM_HEADS, SSM_HEAD_DIM)
    return y, h_final.reshape(bsz, SSM_HEADS, SSM_HEAD_DIM, SSM_STATE)


def ssm_branch(s_z, s_xbc, s_dt, conv_w, conv_b, a_log, dt_bias, d_skip, norm_w, w_out, h0_fwd, h0_bwd):
    bsz, seq = s_z.shape[:2]
    xbc = jax.nn.silu(conv3_centred(s_xbc, conv_w) + conv_b)
    gn = SSM_GROUPS * SSM_STATE
    x = xbc[..., :SSM_INNER].reshape(bsz, seq, SSM_HEADS, SSM_HEAD_DIM).astype(jnp.float32)
    bm = xbc[..., SSM_INNER:SSM_INNER + gn].reshape(bsz, seq, SSM_GROUPS, SSM_STATE).astype(jnp.float32)
    cm = xbc[..., SSM_INNER + gn:].reshape(bsz, seq, SSM_GROUPS, SSM_STATE).astype(jnp.float32)
    dt_raw = s_dt.astype(jnp.float32)
    ys, finals = [], []
    for d, h0 in enumerate((h0_fwd, h0_bwd)):
        dt = jax.nn.softplus(dt_raw + dt_bias[d].astype(jnp.float32))
        a = -jnp.exp(a_log[d].astype(jnp.float32))
        if d == 0:
            y_d, h_d = ssd_chunked(x, dt, a, bm, cm, h0.astype(jnp.float32))
        else:
            y_d, h_d = ssd_chunked(jnp.flip(x, 1), jnp.flip(dt, 1), a, jnp.flip(bm, 1),
                                   jnp.flip(cm, 1), h0.astype(jnp.float32))
            y_d = jnp.flip(y_d, 1)
        ys.append(y_d + d_skip[d].astype(jnp.float32)[:, None] * x)
        finals.append(h_d.astype(s_z.dtype))
    y = (ys[0] + ys[1]).reshape(bsz, seq, SSM_INNER)
    y = rms_norm(y * jax.nn.silu(s_z.astype(jnp.float32)), norm_w).astype(s_z.dtype)
    return y @ w_out, finals[0], finals[1]


def block_attention(q_nope, q_rope, k_nope, k_rope, v):
    bsz, lq = q_nope.shape[:2]
    nb = lq // Q_BLOCK
    scale = 1.0 / math.sqrt(QK_DIM)

    def to_blocks(t):
        return jnp.moveaxis(t.reshape(bsz, nb, Q_BLOCK, *t.shape[2:]), 1, 0)

    def one_block(qb):
        qn, qr = qb
        s = jnp.einsum('bqhd,bkhd->bhqk', qn, k_nope) + jnp.einsum('bqhd,bkd->bhqk', qr, k_rope)
        p = jax.nn.softmax(s.astype(jnp.float32) * scale, axis=-1).astype(v.dtype)
        return jnp.einsum('bhqk,bkhd->bqhd', p, v)

    o = lax.map(one_block, (to_blocks(q_nope), to_blocks(q_rope)))
    return jnp.moveaxis(o, 0, 1).reshape(bsz, lq, MLA_HEADS * V_DIM)


def mla_branch(m_cq, m_ckv, m_kr, q_norm_w, w_uq, kv_norm_w, w_ukv, w_out, ctx_kv, rope_tabs):
    bsz, seq = m_cq.shape[:2]
    q = (rms_norm(m_cq, q_norm_w) @ w_uq).reshape(bsz, seq, MLA_HEADS, QK_DIM)
    q_nope, q_rope = q[..., :NOPE_DIM], q[..., NOPE_DIM:]
    ckv = rms_norm(m_ckv, kv_norm_w)
    if rope_tabs is None:
        ckv_all, kr_all = ckv, m_kr
    else:
        cos, sin = rope_tabs
        q_rope = apply_rope(q_rope, cos[:, None], sin[:, None])
        ckv_all = jnp.concatenate([ctx_kv[0], ckv], axis=1)
        kr_all = jnp.concatenate([ctx_kv[1], apply_rope(m_kr, cos, sin)], axis=1)
    kv = (ckv_all @ w_ukv).reshape(bsz, ckv_all.shape[1], MLA_HEADS, NOPE_DIM + V_DIM)
    out = block_attention(q_nope, q_rope, kv[..., :NOPE_DIM], kr_all, kv[..., NOPE_DIM:])
    return out @ w_out, ckv, m_kr


def trunk_layer(x, cond, p, ctx_kv, h0_fwd, h0_bwd, rope_tabs):
    mod = jax.nn.silu(cond) @ p['w_ada'] + p['b_ada']
    sh1, sc1, g1, sh2, sc2, g2 = [m[:, None, :] for m in jnp.split(mod, 6, axis=-1)]
    h = rms_norm(x, p['norm1_w']) * (1.0 + sc1) + sh1
    a_x, a_b, a_c, s_z, s_xbc, s_dt, m_cq, m_ckv, m_kr, gate_logits = split_columns(h @ p['w_in'])
    y_a = short_conv_branch(a_x, a_b, a_c, p['a_conv_w'], p['w_a_out'])
    y_b, hf, hb = ssm_branch(s_z, s_xbc, s_dt, p['ssm_conv_w'], p['ssm_conv_b'], p['ssm_a_log'],
                             p['ssm_dt_bias'], p['ssm_d'], p['ssm_norm_w'], p['w_b_out'], h0_fwd, h0_bwd)
    y_c, ckv, kr = mla_branch(m_cq, m_ckv, m_kr, p['q_norm_w'], p['w_uq'], p['kv_norm_w'],
                              p['w_ukv'], p['w_c_out'], ctx_kv, rope_tabs)
    gates = jax.nn.sigmoid(gate_logits.astype(jnp.float32)).astype(x.dtype)
    gates = gates.reshape(x.shape[0], x.shape[1], N_BRANCH, D_MODEL)
    merged = gates[..., 0, :] * y_a + gates[..., 1, :] * y_b + gates[..., 2, :] * y_c
    x = x + g1 * (merged @ p['w_o'])
    h2 = rms_norm(x, p['norm2_w']) * (1.0 + sc2) + sh2
    ff = (jax.nn.silu(h2 @ p['w_ff1']) * (h2 @ p['w_ff3'])) @ p['w_ff2']
    x = x + g2 * ff
    return x, ckv, kr, hf, hb


def setup_inputs(seed: int = 0) -> dict:
    key = jax.random.key(seed)
    ks = jax.random.split(key, 32)
    f32 = jnp.float32

    def nrm(k, shape, scale=1.0):
        return jax.random.normal(k, shape, f32) * scale

    def gain(k, shape):
        return 1.0 + 0.1 * jax.random.normal(k, shape, f32)

    dt0 = jnp.exp(jax.random.uniform(ks[13], (DEPTH, 2, SSM_HEADS), f32, math.log(1e-3), math.log(1e-1)))
    st_shape = (DEC_BATCH, DEPTH, SSM_HEADS, SSM_HEAD_DIM, SSM_STATE)
    return {
        'x_prompt': nrm(ks[0], (BATCH, SEQ, D_MODEL)),
        'x_sample': nrm(ks[1], (DEC_BATCH, DEC_SEQ, D_MODEL)),
        'c': nrm(ks[2], (DEC_BATCH, D_MODEL)),
        'cache_ckv': nrm(ks[3], (DEC_BATCH, DEPTH, PAST_LEN, KV_LORA)),
        'cache_krope': nrm(ks[4], (DEC_BATCH, DEPTH, PAST_LEN, ROPE_DIM)),
        'state_ssm_fwd': nrm(ks[5], st_shape, 0.5),
        'state_ssm_bwd': nrm(ks[6], st_shape, 0.5),
        'c_ctx': nrm(ks[7], (D_MODEL,)),
        'w_in': nrm(ks[8], (DEPTH, D_MODEL, IN_COLS), D_MODEL ** -0.5),
        'a_conv_w': nrm(ks[9], (DEPTH, A_CONV, A_WIDTH), A_CONV ** -0.5),
        'w_a_out': nrm(ks[10], (DEPTH, A_WIDTH, D_MODEL), A_WIDTH ** -0.5),
        'ssm_conv_w': nrm(ks[11], (DEPTH, SSM_CONV, SSM_CONV_DIM), SSM_CONV ** -0.5),
        'ssm_conv_b': nrm(ks[12], (DEPTH, SSM_CONV_DIM), 0.02),
        'ssm_a_log': jnp.log(jax.random.uniform(ks[14], (DEPTH, 2, SSM_HEADS), f32, 1.0, 16.0)),
        'ssm_dt_bias': dt0 + jnp.log(-jnp.expm1(-dt0)),
        'ssm_d': gain(ks[15], (DEPTH, 2, SSM_HEADS)),
        'ssm_norm_w': gain(ks[16], (DEPTH, SSM_INNER)),
        'w_b_out': nrm(ks[17], (DEPTH, SSM_INNER, D_MODEL), SSM_INNER ** -0.5),
        'q_norm_w': gain(ks[18], (DEPTH, Q_LORA)),
        'w_uq': nrm(ks[19], (DEPTH, Q_LORA, MLA_HEADS * QK_DIM), Q_LORA ** -0.5),
        'kv_norm_w': gain(ks[20], (DEPTH, KV_LORA)),
        'w_ukv': nrm(ks[21], (DEPTH, KV_LORA, MLA_HEADS * (NOPE_DIM + V_DIM)), KV_LORA ** -0.5),
        'w_c_out': nrm(ks[22], (DEPTH, MLA_HEADS * V_DIM, D_MODEL), (MLA_HEADS * V_DIM) ** -0.5),
        'w_o': nrm(ks[23], (DEPTH, D_MODEL, D_MODEL), D_MODEL ** -0.5),
        'w_ada': nrm(ks[24], (DEPTH, D_MODEL, 6 * D_MODEL), 0.5 * D_MODEL ** -0.5),
        'b_ada': nrm(ks[25], (DEPTH, 6 * D_MODEL), 0.02),
        'norm1_w': gain(ks[26], (DEPTH, D_MODEL)),
        'norm2_w': gain(ks[27], (DEPTH, D_MODEL)),
        'w_ff1': nrm(ks[28], (DEPTH, D_MODEL, FF_DIM), D_MODEL ** -0.5),
        'w_ff3': nrm(ks[29], (DEPTH, D_MODEL, FF_DIM), D_MODEL ** -0.5),
        'w_ff2': nrm(ks[30], (DEPTH, FF_DIM, D_MODEL), FF_DIM ** -0.5),
        'final_norm_w': gain(ks[31], (D_MODEL,)),
    }


def reference(x_prompt, x_sample, c, cache_ckv, cache_krope, state_ssm_fwd, state_ssm_bwd, c_ctx,
              w_in, a_conv_w, w_a_out, ssm_conv_w, ssm_conv_b, ssm_a_log, ssm_dt_bias, ssm_d,
              ssm_norm_w, w_b_out, q_norm_w, w_uq, kv_norm_w, w_ukv, w_c_out, w_o, w_ada, b_ada,
              norm1_w, norm2_w, w_ff1, w_ff3, w_ff2, final_norm_w):
    def layer_params(l):
        return {
            'w_in': w_in[l], 'a_conv_w': a_conv_w[l], 'w_a_out': w_a_out[l],
            'ssm_conv_w': ssm_conv_w[l], 'ssm_conv_b': ssm_conv_b[l], 'ssm_a_log': ssm_a_log[l],
            'ssm_dt_bias': ssm_dt_bias[l], 'ssm_d': ssm_d[l], 'ssm_norm_w': ssm_norm_w[l],
            'w_b_out': w_b_out[l], 'q_norm_w': q_norm_w[l], 'w_uq': w_uq[l], 'kv_norm_w': kv_norm_w[l],
            'w_ukv': w_ukv[l], 'w_c_out': w_c_out[l], 'w_o': w_o[l], 'w_ada': w_ada[l],
            'b_ada': b_ada[l], 'norm1_w': norm1_w[l], 'norm2_w': norm2_w[l],
            'w_ff1': w_ff1[l], 'w_ff3': w_ff3[l], 'w_ff2': w_ff2[l],
        }

    h = x_prompt
    zero_state = jnp.zeros((x_prompt.shape[0], SSM_HEADS, SSM_HEAD_DIM, SSM_STATE), x_prompt.dtype)
    cond_ctx = c_ctx[None, :]
    ckv_list, kr_list, hf_list, hb_list = [], [], [], []
    for l in range(DEPTH):
        h, ckv_l, kr_l, hf_l, hb_l = trunk_layer(h, cond_ctx, layer_params(l), None,
                                                 zero_state, zero_state, None)
        ckv_list.append(ckv_l)
        kr_list.append(kr_l)
        hf_list.append(hf_l)
        hb_list.append(hb_l)
    y_prompt = rms_norm(h, final_norm_w)
    new_ckv = jnp.stack(ckv_list, axis=1)
    new_krope = jnp.stack(kr_list, axis=1)
    new_ssm_fwd = jnp.stack(hf_list, axis=1)
    new_ssm_bwd = jnp.stack(hb_list, axis=1)

    rope_tabs = axial_rope_tables(x_sample.shape[1])
    h = x_sample
    for l in range(DEPTH):
        h, _, _, _, _ = trunk_layer(h, c, layer_params(l), (cache_ckv[:, l], cache_krope[:, l]),
                                    state_ssm_fwd[:, l], state_ssm_bwd[:, l], rope_tabs)
    y_sample = rms_norm(h, final_norm_w)
    return (y_prompt, y_sample, new_ckv, new_krope, new_ssm_fwd, new_ssm_bwd)
```

```cpp
#include <hip/hip_runtime.h>
#include <hip/hip_cooperative_groups.h>
#include <cstdio>
namespace cg = cooperative_groups;

#ifndef PROBE_DUP
#define PROBE_DUP 0
#endif
#ifndef USE_GSYNC
#define USE_GSYNC 0
#endif
#ifndef GEMM_MODE_PROBE
#define GEMM_MODE_PROBE 1
#endif
#ifndef MULTI
#define MULTI 0
#endif

#define DI __device__ __forceinline__
typedef unsigned short u16;
typedef unsigned int u32;
using bf16x8 = __attribute__((ext_vector_type(8))) short;
using f32x16 = __attribute__((ext_vector_type(16))) float;
using u32x4 = __attribute__((ext_vector_type(4))) unsigned;
using u32x2 = __attribute__((ext_vector_type(2))) unsigned;
using f4 = __attribute__((ext_vector_type(4))) float;
typedef __bf16 bf2_t __attribute__((ext_vector_type(2)));
typedef float f2_t __attribute__((ext_vector_type(2)));
#define MFMA(a, b, c) __builtin_amdgcn_mfma_f32_32x32x16_bf16((a), (b), (c), 0, 0, 0)

constexpr int D = 1024, T = 20480, TC = 4096, NLAYER = 4;
constexpr int NPROJ = 4656, INC = 7728, FF = 2816;
constexpr int LDA = 4672;
constexpr int C_AX = 0, C_AB = 512, C_AC = 1024, C_Z = 1536, C_XBC = 2560, C_DT = 4096, C_CQ = 4112, C_CKV = 4368, C_KR = 4624;
constexpr int C_YF = C_XBC, C_YB = 0, C_MERGED = 0, C_U = 0;
constexpr int NKROW = 22528, KROW_CTX = 18432, LKL = 4608;
constexpr float EPS = 1e-6f;

constexpr size_t W_IN = 0;
constexpr size_t W_GATE = W_IN + (size_t)4736 * 1024;
constexpr size_t W_A = W_GATE + (size_t)3072 * 1024;
constexpr size_t W_B = W_A + 1024 * 512;
constexpr size_t W_UQ = W_B + 1024 * 1024;
constexpr size_t W_UKV = W_UQ + 768 * 256;
constexpr size_t W_C = W_UKV + 1024 * 256;
constexpr size_t W_O = W_C + 1024 * 512;
constexpr size_t W_F13 = W_O + 1024 * 1024;
constexpr size_t W_F2 = W_F13 + (size_t)2 * FF * 1024;
constexpr size_t W_END = W_F2 + (size_t)1024 * FF;

constexpr size_t al256(size_t x) { return (x + 255) & ~(size_t)255; }
constexpr size_t WS_W = 0;
constexpr size_t WS_ACT = al256(WS_W + W_END * 2);
constexpr size_t WS_H = al256(WS_ACT + (size_t)T * LDA * 2);
constexpr size_t WS_XT = al256(WS_H + (size_t)T * 1024 * 2);
constexpr size_t WS_BCP = al256(WS_XT + (size_t)T * 1024 * 2);
constexpr size_t WS_BT = al256(WS_BCP + (size_t)T * 512 * 2);
constexpr size_t WS_YA = al256(WS_BT + (size_t)160 * 256 * 128 * 2);
constexpr size_t WS_YC = al256(WS_YA + (size_t)T * 512 * 2);
constexpr size_t WS_Q = al256(WS_YC + (size_t)T * 512 * 2);
constexpr size_t WS_KN = al256(WS_Q + (size_t)T * 768 * 2);
constexpr size_t WS_VT = al256(WS_KN + (size_t)NKROW * 512 * 2);
constexpr size_t WS_KR = al256(WS_VT + (size_t)NKROW * 512 * 2);
constexpr size_t WS_CKVA = al256(WS_KR + (size_t)NKROW * 32 * 2);
constexpr size_t WS_CB = al256(WS_CKVA + (size_t)NKROW * 256 * 2);
constexpr size_t WS_DT = al256(WS_CB + (size_t)320 * 128 * 128 * 2);
constexpr size_t WS_RQ = al256(WS_DT + (size_t)T * 16 * 4);
constexpr size_t WS_RB = al256(WS_RQ + (size_t)T * 4);
constexpr size_t WS_MOD = al256(WS_RB + (size_t)T * 4);
constexpr size_t WS_CTR = al256(WS_MOD + (size_t)NLAYER * 5 * 6144 * 4);
constexpr size_t WS_CUMS = al256(WS_CTR + 4096);
constexpr size_t WS_BAR = al256(WS_CUMS + (size_t)160 * 2 * 16 * 768 * 4);
constexpr size_t WS_END = WS_BAR + 16384;

constexpr size_t O_CKV = 20971520, O_KR = 25165824, O_SF = 25690112, O_SB = 34078720;

struct Params {
  const float* in[34];
  int ph_lo, ph_hi;
};
enum { I_XP = 0, I_XS, I_C, I_CCKV, I_CKR, I_STF, I_STB, I_CCTX, I_WIN, I_ACW, I_WAO, I_SCW, I_SCB, I_ALOG, I_DTB, I_SD, I_SNW, I_WBO,
       I_QNW, I_WUQ, I_KVNW, I_WUKV, I_WCO, I_WO, I_WADA, I_BADA, I_N1, I_N2, I_F1, I_F3, I_F2, I_FNW };

DI int TID() { int t = threadIdx.x; asm volatile("" : "+v"(t)); return t; }
DI int BID() { int b = blockIdx.x; asm volatile("" : "+s"(b)); return b; }
DI const float* KARG(int i) {
  unsigned long long kp = (unsigned long long)__builtin_amdgcn_kernarg_segment_ptr();
  asm volatile("" : "+s"(kp));
  typedef __attribute__((address_space(4))) const unsigned long long* karg_ptr_t;
  typedef __attribute__((address_space(1))) const float* gptr_t;
  return (const float*)(gptr_t)(((karg_ptr_t)kp)[i]);
}
DI unsigned char* WSP(const Params& p) { return (unsigned char*)KARG(33); }
DI float* OUTP(const Params& p) { return (float*)KARG(32); }
DI const float* INP(const Params& p, int i) { return KARG(i); }
DI float bf2f(u16 v) { return __uint_as_float((u32)v << 16); }
DI float bflo(u32 v) { return __uint_as_float(v << 16); }
DI float bfhi(u32 v) { return __uint_as_float(v & 0xffff0000u); }
DI u32 pk2(float a, float b) { f2_t v = {a, b}; bf2_t r = __builtin_convertvector(v, bf2_t); return __builtin_bit_cast(u32, r); }
DI u16 f2bf(float a) { return (u16)(pk2(a, 0.f) & 0xffffu); }
DI float silu_f(float x) { return x / (1.f + __expf(-x)); }
DI float sigmoid_f(float x) { return 1.f / (1.f + __expf(-x)); }
DI float wave_sum(float v) {
#pragma unroll
  for (int o = 1; o < 64; o <<= 1) v += __shfl_xor(v, o);
  return v;
}
DI int crow(int r, int h) { return (r & 3) + 8 * (r >> 2) + 4 * h; }
DI int tile_cb(int mt) { return mt < 32 ? 0 : 1 + ((mt - 32) >> 5); }

__shared__ __attribute__((aligned(16))) unsigned char smem[73728];

template <int MODE = 0>
DI void gemm_tile(const u16* A, int lda, const u16* B, int ldb, int K, f32x16 (&acc)[2][2]) {
  u16* sA = (u16*)smem;
  u16* sB = sA + 2 * 128 * 72;
  const int tid = TID(), lane = tid & 63, w = tid >> 6, wm = w >> 1, wn = w & 1;
  const int lr = tid >> 3, lc = (tid & 7) * 8;
  const u16* ga = A + (size_t)lr * lda + lc;
  const u16* gb = B + (size_t)lr * ldb + lc;
  u32x4 ra[4], rb[4];
#pragma unroll
  for (int p = 0; p < 4; ++p) { ra[p] = *(const u32x4*)(ga + (size_t)(32 * p) * lda); rb[p] = *(const u32x4*)(gb + (size_t)(32 * p) * ldb); }
  __syncthreads();
#pragma unroll
  for (int p = 0; p < 4; ++p) { *(u32x4*)(sA + (lr + 32 * p) * 72 + lc) = ra[p]; *(u32x4*)(sB + (lr + 32 * p) * 72 + lc) = rb[p]; }
  __syncthreads();
  const int nk = K >> 6;
  const int fo_a = (wm * 64 + (lane & 31)) * 72 + (lane >> 5) * 8;
  const int fo_b = (wn * 64 + (lane & 31)) * 72 + (lane >> 5) * 8;
  for (int kt = 0; kt < nk; ++kt) {
    const int cur = kt & 1;
    if (kt + 1 < nk) {
      const int k0 = (kt + 1) * 64;
#pragma unroll
      for (int p = 0; p < 4; ++p) { ra[p] = *(const u32x4*)(ga + (size_t)(32 * p) * lda + k0); rb[p] = *(const u32x4*)(gb + (size_t)(32 * p) * ldb + k0); }
    }
    const u16* pa = sA + cur * 128 * 72 + fo_a;
    const u16* pb = sB + cur * 128 * 72 + fo_b;
#pragma unroll
    for (int ks = 0; ks < 4; ++ks) {
      bf16x8 a0 = *(const bf16x8*)(pa + ks * 16), a1 = *(const bf16x8*)(pa + 32 * 72 + ks * 16);
      bf16x8 b0 = *(const bf16x8*)(pb + ks * 16), b1 = *(const bf16x8*)(pb + 32 * 72 + ks * 16);
      acc[0][0] = MFMA(a0, b0, acc[0][0]); acc[0][1] = MFMA(a0, b1, acc[0][1]);
      acc[1][0] = MFMA(a1, b0, acc[1][0]); acc[1][1] = MFMA(a1, b1, acc[1][1]);
    }
    if (kt + 1 < nk) {
      u16* da = sA + (cur ^ 1) * 128 * 72; u16* db = sB + (cur ^ 1) * 128 * 72;
#pragma unroll
      for (int p = 0; p < 4; ++p) { *(u32x4*)(da + (lr + 32 * p) * 72 + lc) = ra[p]; *(u32x4*)(db + (lr + 32 * p) * 72 + lc) = rb[p]; }
    }
    __syncthreads();
  }
}

template <int MODE = 0>
DI void gemm_tile_wf(const u16* Wfm, int K, int nrow0, const u16* Act, int ldact, f32x16 (&acc)[2][2]) {
  u16* sB = (u16*)smem;
  const int tid = TID(), lane = tid & 63, w = tid >> 6, wm = w >> 1, wn = w & 1;
  const int lr = tid >> 3, lc = (tid & 7) * 8;
  const u16* gb = Act + (size_t)lr * ldact + lc;
  const size_t sb32 = (size_t)32 * ldact;
  const int kq = K >> 4;
  const u16* gw0 = Wfm + ((size_t)((nrow0 >> 5) + wm * 2) * kq) * 512 + lane * 8;
  const u16* gw1 = gw0 + (size_t)kq * 512;
  const int so = lr * 72 + lc;
  const int nk = K >> 6;
  u32x4 rb[4];
  bf16x8 wa[2][4], wb[2][4];
#pragma unroll
  for (int p = 0; p < 4; ++p) rb[p] = *(const u32x4*)(gb + p * sb32);
#pragma unroll
  for (int ks = 0; ks < 4; ++ks) { wa[0][ks] = *(const bf16x8*)(gw0 + ks * 512); wa[1][ks] = *(const bf16x8*)(gw1 + ks * 512); }
  __syncthreads();
#pragma unroll
  for (int p = 0; p < 4; ++p) *(u32x4*)(sB + so + 32 * 72 * p) = rb[p];
  __syncthreads();
  const int fo_b = (wn * 64 + (lane & 31)) * 72 + (lane >> 5) * 8;
  auto compute = [&](int cur, bf16x8 (&wf)[2][4]) {
    const u16* pb = sB + cur * 128 * 72 + fo_b;
#pragma unroll
    for (int ks = 0; ks < 4; ++ks) {
      const bf16x8 b0 = *(const bf16x8*)(pb + ks * 16), b1 = *(const bf16x8*)(pb + 32 * 72 + ks * 16);
      acc[0][0] = MFMA(wf[0][ks], b0, acc[0][0]); acc[0][1] = MFMA(wf[0][ks], b1, acc[0][1]);
      acc[1][0] = MFMA(wf[1][ks], b0, acc[1][0]); acc[1][1] = MFMA(wf[1][ks], b1, acc[1][1]);
    }
  };
  for (int kt = 0; kt < nk; kt += 2) {
    {
      const int k0 = (kt + 1) * 64;
#pragma unroll
      for (int p = 0; p < 4; ++p) rb[p] = *(const u32x4*)(gb + p * sb32 + k0);
#pragma unroll
      for (int ks = 0; ks < 4; ++ks) { wb[0][ks] = *(const bf16x8*)(gw0 + ((kt + 1) * 4 + ks) * 512); wb[1][ks] = *(const bf16x8*)(gw1 + ((kt + 1) * 4 + ks) * 512); }
    }
    compute(0, wa);
#pragma unroll
    for (int p = 0; p < 4; ++p) *(u32x4*)(sB + 128 * 72 + so + 32 * 72 * p) = rb[p];
    __syncthreads();
    {
      const int kn = (kt + 2 < nk) ? kt + 2 : nk - 1;
#pragma unroll
      for (int p = 0; p < 4; ++p) rb[p] = *(const u32x4*)(gb + p * sb32 + kn * 64);
#pragma unroll
      for (int ks = 0; ks < 4; ++ks) { wa[0][ks] = *(const bf16x8*)(gw0 + (kn * 4 + ks) * 512); wa[1][ks] = *(const bf16x8*)(gw1 + (kn * 4 + ks) * 512); }
    }
    compute(1, wb);
    if (kt + 2 < nk) {
#pragma unroll
      for (int p = 0; p < 4; ++p) *(u32x4*)(sB + so + 32 * 72 * p) = rb[p];
    }
    __syncthreads();
  }
}

DI void gemm_tile_wf4(const u16* Wfm, int K, int nrow0, const u16* Act, int ldact, f32x16 (&acc)[4], int Kp = 0, int ks0 = 0) {
  u16* sB = (u16*)smem;
  const int tid = TID(), lane = tid & 63, w = tid >> 6;
  const int lr = tid >> 3, lc = (tid & 7) * 8;
  const u16* gb = Act + (size_t)lr * ldact + lc;
  const size_t sb32 = (size_t)32 * ldact;
  const int kq = K >> 4;
  const u16* gw = Wfm + ((size_t)((nrow0 >> 5) + w) * kq + ks0) * 512 + lane * 8;
  const int so = lr * 72 + lc;
  const int nk = (Kp ? Kp : K) >> 6;
  u32x4 rb[4];
  bf16x8 wa[4], wb[4];
#pragma unroll
  for (int p = 0; p < 4; ++p) rb[p] = *(const u32x4*)(gb + p * sb32);
#pragma unroll
  for (int ks = 0; ks < 4; ++ks) wa[ks] = *(const bf16x8*)(gw + ks * 512);
  __syncthreads();
#pragma unroll
  for (int p = 0; p < 4; ++p) *(u32x4*)(sB + so + 32 * 72 * p) = rb[p];
  __syncthreads();
  const int fo_b = (lane & 31) * 72 + (lane >> 5) * 8;
  auto compute = [&](int cur, bf16x8 (&wf)[4]) {
    const u16* pb = sB + cur * 128 * 72 + fo_b;
#pragma unroll
    for (int ks = 0; ks < 4; ++ks) {
#pragma unroll
      for (int j = 0; j < 4; ++j) acc[j] = MFMA(wf[ks], *(const bf16x8*)(pb + j * 32 * 72 + ks * 16), acc[j]);
    }
  };
  for (int kt = 0; kt < nk; kt += 2) {
    {
      const int k0 = (kt + 1) * 64;
#pragma unroll
      for (int p = 0; p < 4; ++p) rb[p] = *(const u32x4*)(gb + p * sb32 + k0);
#pragma unroll
      for (int ks = 0; ks < 4; ++ks) wb[ks] = *(const bf16x8*)(gw + ((kt + 1) * 4 + ks) * 512);
    }
    compute(0, wa);
#pragma unroll
    for (int p = 0; p < 4; ++p) *(u32x4*)(sB + 128 * 72 + so + 32 * 72 * p) = rb[p];
    __syncthreads();
    {
      const int kn = (kt + 2 < nk) ? kt + 2 : nk - 1;
#pragma unroll
      for (int p = 0; p < 4; ++p) rb[p] = *(const u32x4*)(gb + p * sb32 + kn * 64);
#pragma unroll
      for (int ks = 0; ks < 4; ++ks) wa[ks] = *(const bf16x8*)(gw + (kn * 4 + ks) * 512);
    }
    compute(1, wb);
    if (kt + 2 < nk) {
#pragma unroll
      for (int p = 0; p < 4; ++p) *(u32x4*)(sB + so + 32 * 72 * p) = rb[p];
    }
    __syncthreads();
  }
}
template <class F> DI void stage_bf16_w4(F f) {
  u16* sC = (u16*)smem;
  const int lane = TID() & 63, w = TID() >> 6, h = lane >> 5, c = lane & 31;
#pragma unroll
  for (int j = 0; j < 4; ++j)
#pragma unroll
    for (int g = 0; g < 4; ++g) {
      u32x2 pk; pk[0] = pk2(f(j, 4 * g), f(j, 4 * g + 1)); pk[1] = pk2(f(j, 4 * g + 2), f(j, 4 * g + 3));
      *(u32x2*)(sC + (j * 32 + c) * 136 + w * 32 + 8 * g + 4 * h) = pk;
    }
  __syncthreads();
}

template <class F> DI void stage_bf16_w4u(F f) {
  u16* sC = (u16*)smem;
  const int lane = TID() & 63, w = TID() >> 6, h = lane >> 5, c = lane & 31;
#pragma unroll
  for (int j = 0; j < 4; ++j)
#pragma unroll
    for (int g = 0; g < 2; ++g) {
      u32x2 pk; pk[0] = pk2(f(j, 4 * g), f(j, 4 * g + 1)); pk[1] = pk2(f(j, 4 * g + 2), f(j, 4 * g + 3));
      *(u32x2*)(sC + (j * 32 + c) * 72 + w * 16 + 8 * g + 4 * h) = pk;
    }
  __syncthreads();
}
DI void stage_f32_w4(f32x16 (&acc)[4]) {
  float* sC = (float*)smem;
  const int lane = TID() & 63, w = TID() >> 6, h = lane >> 5, c = lane & 31;
#pragma unroll
  for (int j = 0; j < 4; ++j)
#pragma unroll
    for (int g = 0; g < 4; ++g) {
      f4 v; v[0] = acc[j][4 * g]; v[1] = acc[j][4 * g + 1]; v[2] = acc[j][4 * g + 2]; v[3] = acc[j][4 * g + 3];
      *(f4*)(sC + (j * 32 + c) * 132 + w * 32 + 8 * g + 4 * h) = v;
    }
  __syncthreads();
}
DI void zero_acc(f32x16 (&acc)[2][2]) {
#pragma unroll
  for (int i = 0; i < 2; ++i)
#pragma unroll
    for (int j = 0; j < 2; ++j)
#pragma unroll
      for (int r = 0; r < 16; ++r) acc[i][j][r] = 0.f;
}
template <class F> DI void epi(f32x16 (&acc)[2][2], F f) {
  const int lane = TID() & 63, w = TID() >> 6, wm = w >> 1, wn = w & 1, h = lane >> 5, c = lane & 31;
#pragma unroll
  for (int i = 0; i < 2; ++i)
#pragma unroll
    for (int j = 0; j < 2; ++j)
#pragma unroll
      for (int r = 0; r < 16; ++r) f(wm * 64 + i * 32 + crow(r, h), wn * 64 + j * 32 + c, acc[i][j][r]);
}

template <int W, class F> DI void stage_bf16(F f) {
  u16* sC = (u16*)smem;
  const int lane = TID() & 63, w = TID() >> 6, wm = w >> 1, wn = w & 1, h = lane >> 5, c = lane & 31;
#pragma unroll
  for (int i = 0; i < 2; ++i)
#pragma unroll
    for (int j = 0; j < (W == 128 ? 2 : 1); ++j)
#pragma unroll
      for (int r = 0; r < 16; ++r) sC[(wm * 64 + i * 32 + crow(r, h)) * (W + 8) + wn * (W / 2) + j * 32 + c] = f2bf(f(i, j, r));
  __syncthreads();
}
template <int W> DI void copy_out_bf16(u16* dst, size_t ld, int valid) {
  const u16* sC = (const u16*)smem;
  constexpr int CPR = W / 8;
  const int tid = TID();
#pragma unroll
  for (int q = 0; q < 128 * CPR / 256; ++q) {
    const int id = tid + 256 * q, row = id / CPR, cc = id % CPR;
    if (cc * 8 < valid) *(u32x4*)(dst + (size_t)row * ld + cc * 8) = *(const u32x4*)(sC + row * (W + 8) + cc * 8);
  }
}

template <class F> DI void stage_bf16_sw(F f) {
  u16* sC = (u16*)smem;
  const int lane = TID() & 63, w = TID() >> 6, wm = w >> 1, wn = w & 1, h = lane >> 5, c = lane & 31;
#pragma unroll
  for (int i = 0; i < 2; ++i)
#pragma unroll
    for (int j = 0; j < 2; ++j)
#pragma unroll
      for (int g = 0; g < 4; ++g) {
        u32x2 pk; pk[0] = pk2(f(i, j, 4 * g), f(i, j, 4 * g + 1)); pk[1] = pk2(f(i, j, 4 * g + 2), f(i, j, 4 * g + 3));
        *(u32x2*)(sC + (wn * 64 + j * 32 + c) * 136 + wm * 64 + i * 32 + 8 * g + 4 * h) = pk;
      }
  __syncthreads();
}
template <class F> DI void stage_bf16_sw64(F f) {
  u16* sC = (u16*)smem;
  const int lane = TID() & 63, w = TID() >> 6, wm = w >> 1, wn = w & 1, h = lane >> 5, c = lane & 31;
#pragma unroll
  for (int j = 0; j < 2; ++j)
#pragma unroll
    for (int g = 0; g < 4; ++g) {
      u32x2 pk; pk[0] = pk2(f(j, 4 * g), f(j, 4 * g + 1)); pk[1] = pk2(f(j, 4 * g + 2), f(j, 4 * g + 3));
      *(u32x2*)(sC + (wn * 64 + j * 32 + c) * 72 + wm * 32 + 8 * g + 4 * h) = pk;
    }
  __syncthreads();
}
DI void stage_f32(f32x16 (&acc)[2][2]) {
  float* sC = (float*)smem;
  const int lane = TID() & 63, w = TID() >> 6, wm = w >> 1, wn = w & 1, h = lane >> 5, c = lane & 31;
#pragma unroll
  for (int i = 0; i < 2; ++i)
#pragma unroll
    for (int j = 0; j < 2; ++j)
#pragma unroll
      for (int r = 0; r < 16; ++r) sC[(wm * 64 + i * 32 + crow(r, h)) * 132 + wn * 64 + j * 32 + c] = acc[i][j][r];
  __syncthreads();
}
DI int vblock() { const int nb = gridDim.x, b = BID(); return (nb & 7) ? b : (b & 7) * (nb >> 3) + (b >> 3); }
DI void decode_tile(int idx, int NT, int& mt, int& nt) { const int g = idx / (8 * NT); const int r = idx - g * 8 * NT; nt = r >> 3; mt = g * 8 + (r & 7); }


DI void group_sync(const Params& p, int& nbar) {
  if (!USE_GSYNC) return;
  __syncthreads();
  nbar += 1;
  if ((gridDim.x & 7) == 0 && TID() == 0) {
    u32* c = (u32*)(WSP(p) + WS_CTR) + 64 + 32 * (BID() & 7);
    const u32 target = (gridDim.x >> 3) * (u32)nbar;
    __hip_atomic_fetch_add(c, 1u, __ATOMIC_RELAXED, __HIP_MEMORY_SCOPE_AGENT);
    while (__hip_atomic_load(c, __ATOMIC_RELAXED, __HIP_MEMORY_SCOPE_AGENT) < target) __builtin_amdgcn_s_sleep(1);
  }
  __syncthreads();
}
#define TILE_LOOP(NT_TOTAL) \
  for (int rd_ = 0, idx = vblock(); rd_ < ((NT_TOTAL) + (int)gridDim.x - 1) / (int)gridDim.x; ++rd_, idx += gridDim.x)


#define XB_TMO      128
#define XB_XCNT(j)  (256  + 64 * (j))
#define XB_XSUB(j)  (1280 + 64 * (j))
#define XB_XGEN(j)  (2304 + 64 * (j))
#define XB_TOP      3328
#define XB_TOPGEN   3392
#define XCD_BAR_WORDS 3456
#define XB_SPIN_CAP (1u << 20)
#define LAS __attribute__((address_space(3)))
DI unsigned xb_ld(unsigned* p) { return __hip_atomic_load(p, __ATOMIC_RELAXED, __HIP_MEMORY_SCOPE_AGENT); }
DI unsigned xb_add(unsigned* p, unsigned v) { return __hip_atomic_fetch_add(p, v, __ATOMIC_RELAXED, __HIP_MEMORY_SCOPE_AGENT); }
DI unsigned xb_xcc_id() { return (unsigned)__builtin_amdgcn_s_getreg((3 << 11) | 20) & 0xFu; }
#define XB_SPIN(cond, bar) do { unsigned _sp = 0; while (cond) { __builtin_amdgcn_s_sleep(1); \
    if ((++_sp & 255u) == 0u) { if (xb_ld(&(bar)[XB_TMO])) break; if (_sp > XB_SPIN_CAP) { atomicAdd(&(bar)[XB_TMO], 1u); break; } } } } while (0)
__shared__ uint4 xb_words;
DI void xcd_barrier_complete(unsigned* bar, unsigned x, unsigned& nloc, unsigned& nx) {
  const unsigned G = gridDim.x;
  unsigned sum, cnt, mine, sp = 0u;
  for (;;) {
    sum = 0u; cnt = 0u; mine = 0u;
#pragma unroll
    for (unsigned j = 0; j < 16; ++j) { const unsigned c = xb_ld(&bar[XB_XCNT(j)]); sum += c; cnt += (c > 0u) ? 1u : 0u; mine = (j == x) ? c : mine; }
    if (sum == G) break;
    __builtin_amdgcn_s_sleep(1);
    if ((++sp & 255u) == 0u) { if (xb_ld(&bar[XB_TMO])) break; if (sp > XB_SPIN_CAP) { atomicAdd(&bar[XB_TMO], 1u); break; } }
  }
  nloc = mine > 0u ? mine : 1u; nx = cnt > 0u ? cnt : 1u;
}
DI void gsync(const Params& p) {
  asm volatile("s_waitcnt vmcnt(0)" ::: "memory");
  __syncthreads();
  if (threadIdx.x == 0) {
    unsigned* bar = (unsigned*)(WSP(p) + WS_BAR);
    volatile LAS unsigned* st = (volatile LAS unsigned*)&xb_words;
    const unsigned x = xb_xcc_id();
    __builtin_amdgcn_s_waitcnt(0);
    unsigned nloc = st[0], nx = st[1];
    if (nloc == 0u) { xcd_barrier_complete(bar, x, nloc, nx); st[0] = nloc; st[1] = nx; }
    const unsigned old = xb_add(&bar[XB_XSUB(x)], 1u);
    const unsigned gen = old / nloc;
    if (old + 1u == (gen + 1u) * nloc) {
      __builtin_amdgcn_fence(__ATOMIC_RELEASE, "agent");
      asm volatile("s_waitcnt vmcnt(0)" ::: "memory");
      const unsigned og = xb_add(&bar[XB_TOP], 1u);
      const unsigned tg = og / nx;
      if (og + 1u == (tg + 1u) * nx) xb_add(&bar[XB_TOPGEN], 1u);
      else XB_SPIN(xb_ld(&bar[XB_TOPGEN]) == tg, bar);
      __builtin_amdgcn_fence(__ATOMIC_ACQUIRE, "agent");
      xb_add(&bar[XB_XGEN(x)], 1u);
      asm volatile("s_waitcnt vmcnt(0)" ::: "memory");
    } else {
      XB_SPIN(xb_ld(&bar[XB_XGEN(x)]) == gen, bar);
      __builtin_amdgcn_fence(__ATOMIC_ACQUIRE, "agent");
      asm volatile("s_waitcnt vmcnt(0)" ::: "memory");
    }
  }
  __syncthreads();
}

DI void conv_matrix(const float* src, int K, int ldn, int N, u16* dst, const float* scale, int mode, int off, int rot) {
  float* sm = (float*)smem;
  const int tid = TID(), nb = gridDim.x;
  const int nkt = K >> 6, nnt = (N + 63) >> 6;
  int b0 = BID() - rot; if (b0 < 0) b0 += nb;
  for (int it = b0; it < nkt * nnt; it += nb) {
    const int kt = it % nkt, nt = it / nkt, k0 = kt * 64, n0 = nt * 64;
    __syncthreads();
    const int r = tid >> 4, c4 = (tid & 15) * 4;
#pragma unroll
    for (int p = 0; p < 4; ++p) {
      const int k = r + 16 * p;
      f4 v = {0.f, 0.f, 0.f, 0.f};
      if (n0 + c4 < N) v = *(const f4*)(src + (size_t)(k0 + k) * ldn + n0 + c4);
      if (scale) { const float s = scale[k0 + k]; v *= s; }
      sm[k * 65 + c4 + 0] = v[0]; sm[k * 65 + c4 + 1] = v[1]; sm[k * 65 + c4 + 2] = v[2]; sm[k * 65 + c4 + 3] = v[3];
    }
    __syncthreads();
    const int n = tid & 63, kc = tid >> 6;
    if (n0 + n < N) {
      const int ng = n0 + n;
      const int row = (mode & 4) ? ((ng >> 4) * 32 + (ng & 15) + off) : (mode & 1) ? ((ng >> 5) * 64 + (ng & 31) + off) : ng;
#pragma unroll
      for (int q = 0; q < 2; ++q) {
        const int c = kc + 4 * q;
        const float* s = sm + (8 * c) * 65 + n;
        u32x4 o;
        o[0] = pk2(s[0], s[65]); o[1] = pk2(s[2 * 65], s[3 * 65]); o[2] = pk2(s[4 * 65], s[5 * 65]); o[3] = pk2(s[6 * 65], s[7 * 65]);
        if (mode & 2) *(u32x4*)(dst + ((size_t)(row >> 5) * (K >> 4) + ((k0 + 8 * c) >> 4)) * 512 + (((k0 + 8 * c) >> 3) & 1) * 256 + (row & 31) * 8) = o;
        else *(u32x4*)(dst + (size_t)row * K + k0 + 8 * c) = o;
      }
    }
  }
}

DI void norm_phase(const Params& p, int l, int which) {
  const float* X = OUTP(p);
  u16* H = (u16*)(WSP(p) + WS_H);
  const float* nw = INP(p, which ? I_N2 : I_N1) + l * 1024;
  const float* MOD = (const float*)(WSP(p) + WS_MOD) + (size_t)l * 5 * 6144;
  const int lane = TID() & 63, gw = BID() * 4 + (TID() >> 6), nw_ = gridDim.x * 4;
  for (int t = gw; t < T; t += nw_) {
    const int cb = t < TC ? 0 : 1 + ((t - TC) >> 12);
    const float* sh = MOD + cb * 6144 + (which ? 3 : 0) * 1024;
    const float* sc = sh + 1024;
    const f4* xr = (const f4*)(X + (size_t)t * 1024) + lane;
    f4 v[4]; float s = 0.f;
#pragma unroll
    for (int j = 0; j < 4; ++j) { v[j] = xr[64 * j]; s += v[j][0] * v[j][0] + v[j][1] * v[j][1] + v[j][2] * v[j][2] + v[j][3] * v[j][3]; }
    const float rstd = rsqrtf(wave_sum(s) * (1.f / 1024.f) + EPS);
#pragma unroll
    for (int j = 0; j < 4; ++j) {
      const int c = 4 * lane + 256 * j;
      const f4 wv = *(const f4*)(nw + c), scv = *(const f4*)(sc + c), shv = *(const f4*)(sh + c);
      float o[4];
#pragma unroll
      for (int e = 0; e < 4; ++e) o[e] = v[j][e] * rstd * wv[e] * (1.f + scv[e]) + shv[e];
      u32x2 pk; pk[0] = pk2(o[0], o[1]); pk[1] = pk2(o[2], o[3]);
      *(u32x2*)(H + (size_t)t * 1024 + c) = pk;
    }
  }
}

DI void pre_phase(const Params& p) {
  const int tid = TID(), nb = gridDim.x;
  if (BID() == 0) { for (int i = tid; i < 1024; i += 256) ((u32*)(WSP(p) + WS_CTR))[i] = 0u; }
  {
    f4* X4 = (f4*)OUTP(p);
    const f4* xp = (const f4*)INP(p, I_XP); const f4* xs = (const f4*)INP(p, I_XS);
    const int n4 = T * 256, nc4 = TC * 256;
    for (int i = BID() * 256 + tid; i < n4; i += nb * 256) X4[i] = (i < nc4) ? xp[i] : xs[i - nc4];
  }
  float* sm = (float*)smem;
  float* MOD = (float*)(WSP(p) + WS_MOD);
  __syncthreads();
  for (int i = tid; i < 5 * 1024; i += 256) {
    const int cb = i >> 10, k = i & 1023;
    const float cv = cb == 0 ? INP(p, I_CCTX)[k] : INP(p, I_C)[(cb - 1) * 1024 + k];
    sm[i] = silu_f(cv);
  }
  __syncthreads();
  float* red = sm + 5 * 1024;
  for (int it = BID(); it < NLAYER * 48; it += nb) {
    const int l = it / 48, n0 = (it % 48) * 128;
    const int c4 = (tid & 31) * 4, kg = tid >> 5;
    float a[5][4];
#pragma unroll
    for (int cb = 0; cb < 5; ++cb)
#pragma unroll
      for (int e = 0; e < 4; ++e) a[cb][e] = 0.f;
    const float* wsrc = INP(p, I_WADA) + (size_t)l * 1024 * 6144 + n0 + c4;
    for (int k = kg * 128; k < kg * 128 + 128; ++k) {
      const f4 wv = *(const f4*)(wsrc + (size_t)k * 6144);
#pragma unroll
      for (int cb = 0; cb < 5; ++cb) {
        const float s = sm[cb * 1024 + k];
#pragma unroll
        for (int e = 0; e < 4; ++e) a[cb][e] += s * wv[e];
      }
    }
    __syncthreads();
#pragma unroll
    for (int cb = 0; cb < 5; ++cb)
#pragma unroll
      for (int e = 0; e < 4; ++e) red[(kg * 5 + cb) * 128 + c4 + e] = a[cb][e];
    __syncthreads();
    for (int o = tid; o < 5 * 128; o += 256) {
      const int cb = o >> 7, n = o & 127;
      float s = INP(p, I_BADA)[l * 6144 + n0 + n];
#pragma unroll
      for (int g = 0; g < 8; ++g) s += red[(g * 5 + cb) * 128 + n];
      MOD[((size_t)l * 5 + cb) * 6144 + n0 + n] = s;
    }
  }
}

DI void l1_phase(const Params& p, int l) {
  u16* W = (u16*)(WSP(p) + WS_W);
  conv_matrix(INP(p, I_WIN) + (size_t)l * 1024 * INC, 1024, INC, NPROJ, W + W_IN, nullptr, 2, 0, 0);
  conv_matrix(INP(p, I_WIN) + (size_t)l * 1024 * INC + NPROJ, 1024, INC, 3072, W + W_GATE, nullptr, 2, 0, 300);
  conv_matrix(INP(p, I_F1) + (size_t)l * 1024 * FF, 1024, FF, FF, W + W_F13, nullptr, 6, 0, 64);
  conv_matrix(INP(p, I_F3) + (size_t)l * 1024 * FF, 1024, FF, FF, W + W_F13, nullptr, 6, 16, 128);
  conv_matrix(INP(p, I_F2) + (size_t)l * FF * 1024, FF, 1024, 1024, W + W_F2, nullptr, 2, 0, 192);
  conv_matrix(INP(p, I_WAO) + (size_t)l * 512 * 1024, 512, 1024, 1024, W + W_A, nullptr, 2, 0, 32);
  conv_matrix(INP(p, I_WBO) + (size_t)l * 1024 * 1024, 1024, 1024, 1024, W + W_B, INP(p, I_SNW) + l * 1024, 2, 0, 96);
  conv_matrix(INP(p, I_WUQ) + (size_t)l * 256 * 768, 256, 768, 768, W + W_UQ, INP(p, I_QNW) + l * 256, 0, 0, 160);
  conv_matrix(INP(p, I_WUKV) + (size_t)l * 256 * 1024, 256, 1024, 1024, W + W_UKV, nullptr, 0, 0, 224);
  conv_matrix(INP(p, I_WCO) + (size_t)l * 512 * 1024, 512, 1024, 1024, W + W_C, nullptr, 2, 0, 16);
  conv_matrix(INP(p, I_WO) + (size_t)l * 1024 * 1024, 1024, 1024, 1024, W + W_O, nullptr, 2, 0, 80);
  norm_phase(p, l, 0);
}

DI void l2_phase(const Params& p, int l, int& nbar) {
  const u16* H = (const u16*)(WSP(p) + WS_H);
  const u16* W = (const u16*)(WSP(p) + WS_W) + W_IN;
  u16* ACT = (u16*)(WSP(p) + WS_ACT);
  float* DT = (float*)(WSP(p) + WS_DT);
  constexpr int NT = 37;
  TILE_LOOP(160 * NT) {
    group_sync(p, nbar);
    if (idx >= 160 * NT) continue;
    int mt, nt; decode_tile(idx, NT, mt, nt);
    f32x16 acc[4];
#pragma unroll
    for (int j = 0; j < 4; ++j)
#pragma unroll
      for (int r = 0; r < 16; ++r) acc[j][r] = 0.f;
    gemm_tile_wf4(W, 1024, nt * 128, H + (size_t)mt * 128 * 1024, 1024, acc);
    const int m0 = mt * 128, n0 = nt * 128;
    if (nt == 32 || (nt == 36 && mt < 32)) {
      const int lane = TID() & 63, w = TID() >> 6, h = lane >> 5, c = lane & 31;
#pragma unroll
      for (int j = 0; j < 4; ++j)
#pragma unroll
        for (int r = 0; r < 16; ++r) {
          const int t = m0 + j * 32 + c, cc = n0 + w * 32 + crow(r, h);
          const float v = acc[j][r];
          if (cc >= C_DT && cc < C_DT + 16) DT[t * 16 + cc - C_DT] = v;
          if (cc >= C_KR && cc < NPROJ && t < TC) OUTP(p)[O_KR + ((size_t)((t >> 8) * 4 + l) * 256 + (t & 255)) * 32 + (cc - C_KR)] = v;
        }
    }
    stage_bf16_w4([&](int j, int r) { return acc[j][r]; });
    copy_out_bf16<128>(ACT + (size_t)m0 * LDA + n0, LDA, NPROJ - n0);
  }
}

DI void unpack8(const u32x4 v, float (&f)[8]) {
#pragma unroll
  for (int i = 0; i < 4; ++i) { f[2 * i] = bflo(v[i]); f[2 * i + 1] = bfhi(v[i]); }
}
DI u32x4 pack8(const float (&f)[8]) { u32x4 o; o[0] = pk2(f[0], f[1]); o[1] = pk2(f[2], f[3]); o[2] = pk2(f[4], f[5]); o[3] = pk2(f[6], f[7]); return o; }

DI void l3_phase(const Params& p, int l) {
  const u16* ACT = (const u16*)(WSP(p) + WS_ACT);
  const int tid = TID(), nb = gridDim.x;
  {
    u16* YA = (u16*)(WSP(p) + WS_YA);
    const float* cw = INP(p, I_ACW) + l * 3 * 512;
    for (int it = BID() * 256 + tid; it < T * 64; it += nb * 256) {
      const int t = it >> 6, c8 = (it & 63) * 8;
      const int pos = t < TC ? (t & 255) : ((t - TC) & 4095);
      const int L = t < TC ? 256 : 4096;
      const u16* row = ACT + (size_t)t * LDA;
      float u0[8], u1[8], u2[8], ab[8], a1[8], a2[8];
      unpack8(*(const u32x4*)(row + C_AX + c8), a1); unpack8(*(const u32x4*)(row + C_AC + c8), a2);
#pragma unroll
      for (int e = 0; e < 8; ++e) u1[e] = a1[e] * a2[e];
      if (pos > 0) {
        unpack8(*(const u32x4*)(row - LDA + C_AX + c8), a1); unpack8(*(const u32x4*)(row - LDA + C_AC + c8), a2);
#pragma unroll
        for (int e = 0; e < 8; ++e) u0[e] = a1[e] * a2[e];
      } else {
#pragma unroll
        for (int e = 0; e < 8; ++e) u0[e] = 0.f;
      }
      if (pos < L - 1) {
        unpack8(*(const u32x4*)(row + LDA + C_AX + c8), a1); unpack8(*(const u32x4*)(row + LDA + C_AC + c8), a2);
#pragma unroll
        for (int e = 0; e < 8; ++e) u2[e] = a1[e] * a2[e];
      } else {
#pragma unroll
        for (int e = 0; e < 8; ++e) u2[e] = 0.f;
      }
      unpack8(*(const u32x4*)(row + C_AB + c8), ab);
      float o[8];
#pragma unroll
      for (int e = 0; e < 8; ++e) o[e] = ab[e] * (cw[c8 + e] * u0[e] + cw[512 + c8 + e] * u1[e] + cw[1024 + c8 + e] * u2[e]);
      *(u32x4*)(YA + (size_t)t * 512 + c8) = pack8(o);
    }
  }
  {
    u16* XT = (u16*)(WSP(p) + WS_XT); u16* BCP = (u16*)(WSP(p) + WS_BCP); u16* BT = (u16*)(WSP(p) + WS_BT);
    const float* cw = INP(p, I_SCW) + l * 3 * 1536;
    const float* cbias = INP(p, I_SCB) + l * 1536;
    u16* sr = (u16*)smem;
    for (int it = BID(); it < 160 * 24; it += nb) {
      const int chunk = it / 24, cbk = it % 24, ch0 = cbk * 64, t0 = chunk * 128;
      const bool first = chunk < 32 ? ((chunk & 1) == 0) : (((chunk - 32) & 31) == 0);
      const bool last = chunk < 32 ? ((chunk & 1) == 1) : (((chunk - 32) & 31) == 31);
      __syncthreads();
      for (int id = tid; id < 130 * 8; id += 256) {
        const int r = id >> 3, c8 = (id & 7) * 8;
        u32x4 v = {0u, 0u, 0u, 0u};
        const bool ok = !((r == 0 && first) || (r == 129 && last));
        if (ok) v = *(const u32x4*)(ACT + (size_t)(t0 - 1 + r) * LDA + C_XBC + ch0 + c8);
        *(u32x4*)(sr + r * 72 + c8) = v;
      }
      __syncthreads();
      if (cbk >= 16) {
        const int c8 = (tid & 7) * 8;
        float w0[8], w1[8], w2[8], bb[8];
#pragma unroll
        for (int e = 0; e < 8; ++e) { w0[e] = cw[ch0 + c8 + e]; w1[e] = cw[1536 + ch0 + c8 + e]; w2[e] = cw[3072 + ch0 + c8 + e]; bb[e] = cbias[ch0 + c8 + e]; }
#pragma unroll
        for (int q = 0; q < 4; ++q) {
          const int r = (tid >> 3) + 32 * q;
          float x0[8], x1[8], x2[8], o[8];
          unpack8(*(const u32x4*)(sr + r * 72 + c8), x0); unpack8(*(const u32x4*)(sr + (r + 1) * 72 + c8), x1); unpack8(*(const u32x4*)(sr + (r + 2) * 72 + c8), x2);
#pragma unroll
          for (int e = 0; e < 8; ++e) o[e] = silu_f(w0[e] * x0[e] + w1[e] * x1[e] + w2[e] * x2[e] + bb[e]);
          *(u32x4*)(BCP + (size_t)(t0 + r) * 512 + (ch0 - 1024) + c8) = pack8(o);
        }
      }
      if (cbk < 20) {
        const int ch = tid & 63, jg0 = tid >> 6;
        const float w0 = cw[ch0 + ch], w1 = cw[1536 + ch0 + ch], w2 = cw[3072 + ch0 + ch], bb = cbias[ch0 + ch];
        u16* dst = cbk < 16 ? XT + ((size_t)chunk * 1024 + ch0 + ch) * 128 : BT + ((size_t)chunk * 256 + (ch0 - 1024) + ch) * 128;
#pragma unroll
        for (int q = 0; q < 4; ++q) {
          const int g = jg0 + 4 * q;
          float xv[10], o[8];
#pragma unroll
          for (int e = 0; e < 10; ++e) xv[e] = bf2f(sr[(8 * g + e) * 72 + ch]);
#pragma unroll
          for (int e = 0; e < 8; ++e) o[e] = silu_f(w0 * xv[e] + w1 * xv[e + 1] + w2 * xv[e + 2] + bb);
          *(u32x4*)(dst + 8 * g) = pack8(o);
        }
      }
    }
  }
  {
    u16* CKVA = (u16*)(WSP(p) + WS_CKVA); u16* KRA = (u16*)(WSP(p) + WS_KR);
    float* RQ = (float*)(WSP(p) + WS_RQ);
    const float* kvw = INP(p, I_KVNW) + l * 256;
    const int lane = tid & 63, gw = BID() * 4 + (tid >> 6), nwv = nb * 4;
    for (int it = gw; it < T + 2048; it += nwv) {
      if (it < T) {
        const int t = it;
        const u16* row = ACT + (size_t)t * LDA;
        const u32x2 kv = *(const u32x2*)(row + C_CKV + 4 * lane);
        const u32x2 qv = *(const u32x2*)(row + C_CQ + 4 * lane);
        float k4[4] = {bflo(kv[0]), bfhi(kv[0]), bflo(kv[1]), bfhi(kv[1])};
        float q4[4] = {bflo(qv[0]), bfhi(qv[0]), bflo(qv[1]), bfhi(qv[1])};
        const float ssk = wave_sum(k4[0] * k4[0] + k4[1] * k4[1] + k4[2] * k4[2] + k4[3] * k4[3]);
        const float ssq = wave_sum(q4[0] * q4[0] + q4[1] * q4[1] + q4[2] * q4[2] + q4[3] * q4[3]);
        const float rk = rsqrtf(ssk * (1.f / 256.f) + EPS);
        if (lane == 0) RQ[t] = rsqrtf(ssq * (1.f / 256.f) + EPS);
        const f4 wv = *(const f4*)(kvw + 4 * lane);
        f4 o; o[0] = k4[0] * rk * wv[0]; o[1] = k4[1] * rk * wv[1]; o[2] = k4[2] * rk * wv[2]; o[3] = k4[3] * rk * wv[3];
        int krow, pos;
        if (t < TC) { krow = KROW_CTX + t; pos = t & 255; *(f4*)(OUTP(p) + O_CKV + ((size_t)((t >> 8) * 4 + l) * 256 + pos) * 256 + 4 * lane) = o; }
        else { const int b = (t - TC) >> 12; pos = (t - TC) & 4095; krow = b * LKL + 512 + pos; }
        u32x2 pk; pk[0] = pk2(o[0], o[1]); pk[1] = pk2(o[2], o[3]);
        *(u32x2*)(CKVA + (size_t)krow * 256 + 4 * lane) = pk;
        if (lane < 16) {
          float x1 = bf2f(row[C_KR + lane]), x2 = bf2f(row[C_KR + 16 + lane]);
          if (t >= TC) {
            const float pp = (lane < 8) ? (float)(pos >> 6) : (float)(pos & 63);
            const float inv = exp2f(-(float)(lane & 7) * (13.287712379549449f / 8.f));
            const float ang = pp * inv;
            const float cs = cosf(ang), sn = sinf(ang);
            const float y1 = x1 * cs - x2 * sn, y2 = x1 * sn + x2 * cs;
            x1 = y1; x2 = y2;
          }
          KRA[(size_t)krow * 32 + lane] = f2bf(x1); KRA[(size_t)krow * 32 + 16 + lane] = f2bf(x2);
        }
      } else {
        const int j = it - T, b = j >> 9, r = j & 511;
        const int krow = b * LKL + r;
        const f4 v = *(const f4*)(INP(p, I_CCKV) + ((size_t)(b * 4 + l) * 512 + r) * 256 + 4 * lane);
        u32x2 pk; pk[0] = pk2(v[0], v[1]); pk[1] = pk2(v[2], v[3]);
        *(u32x2*)(CKVA + (size_t)krow * 256 + 4 * lane) = pk;
        if (lane < 32) KRA[(size_t)krow * 32 + lane] = f2bf(INP(p, I_CKR)[((size_t)(b * 4 + l) * 512 + r) * 32 + lane]);
      }
    }
  }
}

DI void l3d_phase(const Params& p, int l) {
  const float* DT = (const float*)(WSP(p) + WS_DT);
  float* CUMS = (float*)(WSP(p) + WS_CUMS);
  const int tid = TID(), lane = tid & 63, gw = BID() * 4 + (tid >> 6), nwv = gridDim.x * 4;
  for (int it = gw; it < 160 * 32; it += nwv) {
    const int chunk = it >> 5, dir = (it >> 4) & 1, head = it & 15, t0 = chunk * 128;
    const float a = -__expf(INP(p, I_ALOG)[(l * 2 + dir) * 16 + head]);
    const float dtb = INP(p, I_DTB)[(l * 2 + dir) * 16 + head];
    const int k0 = 2 * lane, k1 = 2 * lane + 1;
    const int tk0 = dir ? 127 - k0 : k0, tk1 = dir ? 127 - k1 : k1;
    const float x0 = DT[(t0 + tk0) * 16 + head] + dtb, x1 = DT[(t0 + tk1) * 16 + head] + dtb;
    const float d0 = x0 > 20.f ? x0 : log1pf(__expf(x0)), d1 = x1 > 20.f ? x1 : log1pf(__expf(x1));
    const float v0 = d0 * a, v1 = d1 * a;
    float s = v0 + v1;
#pragma unroll
    for (int o = 1; o < 64; o <<= 1) { const float n = __shfl_up(s, o); if (lane >= o) s += n; }
    const float total = __shfl(s, 63);
    const float c1 = s, c0 = s - v1;
    float* cs = CUMS + (size_t)it * 768;
    const float cref = __shfl(c1, (lane & ~7) | 7);
    cs[tk0] = c0; cs[tk1] = c1; cs[128 + tk0] = __expf(cref - c0) * d0; cs[128 + tk1] = __expf(cref - c1) * d1;
    cs[640 + tk0] = d0; cs[640 + tk1] = d1;
    {
      const float cfirst = __shfl(c0, lane & ~7);
      if ((lane & 7) == 7) { cs[520 + (tk1 >> 4)] = c1; cs[528 + (tk1 >> 4)] = cfirst - c1; }
    }
    cs[256 + tk0] = __expf(total - c0) * d0; cs[256 + tk1] = __expf(total - c1) * d1;
    cs[384 + tk0] = __expf(c0); cs[384 + tk1] = __expf(c1);
    if (lane == 0) cs[512] = __expf(total);
  }
}

DI void l4_phase(const Params& p, int l, int& nbar) {
  constexpr int NQ = 160 * 6, NKV = 176 * 8, NCB = 320;
  TILE_LOOP(NQ + NKV + NCB) {
    group_sync(p, nbar);
    if (idx >= NQ + NKV + NCB) continue;
    const u16* W = (const u16*)(WSP(p) + WS_W);
    const u16* ACT = (const u16*)(WSP(p) + WS_ACT);
    f32x16 acc[2][2]; zero_acc(acc);
    if (idx < NQ) {
      int mt, nt; decode_tile(idx, 6, mt, nt);
      gemm_tile(W + W_UQ + (size_t)nt * 128 * 256, 256, ACT + (size_t)mt * 128 * LDA + C_CQ, LDA, 256, acc);
      const float* RQ = (const float*)(WSP(p) + WS_RQ);
      u16* Q = (u16*)(WSP(p) + WS_Q);
      const int m0 = mt * 128, n0 = nt * 128;
      {
        const int lane = TID() & 63, w = TID() >> 6, wn = w & 1, c = lane & 31;
        const float rq0 = RQ[m0 + wn * 64 + c], rq1 = RQ[m0 + wn * 64 + 32 + c];
        stage_bf16_sw([&](int i, int j, int r) { return acc[i][j][r] * (j ? rq1 : rq0); });
        copy_out_bf16<128>(Q + (size_t)m0 * 768 + n0, 768, 128);
      }
    } else if (idx < NQ + NKV) {
      int mt, nt; decode_tile(idx - NQ, 8, mt, nt);
      gemm_tile((const u16*)(WSP(p) + WS_CKVA) + (size_t)mt * 128 * 256, 256, W + W_UKV + (size_t)nt * 128 * 256, 256, 256, acc);
      u16* KN = (u16*)(WSP(p) + WS_KN); u16* VT = (u16*)(WSP(p) + WS_VT);
      const int lane = TID() & 63, w = TID() >> 6, wm = w >> 1, wn = w & 1, h = lane >> 5, c = lane & 31;
      const int kr0 = mt * 128;
      size_t vbase; int Lk, key0;
      if (kr0 < KROW_CTX) { const int b = kr0 / LKL; key0 = kr0 - b * LKL; Lk = LKL; vbase = (size_t)b * 512 * LKL; }
      else { const int s = (kr0 - KROW_CTX) >> 8; key0 = (kr0 - KROW_CTX) & 255; Lk = 256; vbase = (size_t)4 * 512 * LKL + (size_t)s * 512 * 256; }
#pragma unroll
      for (int i = 0; i < 2; ++i)
#pragma unroll
        for (int j = 0; j < 2; ++j) {
          const int d = j * 32 + c;
          if (wn == 0) {
#pragma unroll
            for (int r = 0; r < 16; ++r) KN[(size_t)(kr0 + wm * 64 + i * 32 + crow(r, h)) * 512 + nt * 64 + d] = f2bf(acc[i][j][r]);
          } else {
#pragma unroll
            for (int g = 0; g < 4; ++g) {
              const int key = key0 + wm * 64 + i * 32 + 8 * g + 4 * h;
              u32x2 pk; pk[0] = pk2(acc[i][j][4 * g], acc[i][j][4 * g + 1]); pk[1] = pk2(acc[i][j][4 * g + 2], acc[i][j][4 * g + 3]);
              *(u32x2*)(VT + vbase + (size_t)(nt * 64 + d) * Lk + key) = pk;
            }
          }
        }
    } else {
      const int ci = idx - NQ - NKV, chunk = ci >> 1, g = ci & 1;
      const u16* BCP = (const u16*)(WSP(p) + WS_BCP) + (size_t)chunk * 128 * 512;
      gemm_tile(BCP + 256 + g * 128, 512, BCP + g * 128, 512, 128, acc);
      u16* CB = (u16*)(WSP(p) + WS_CB) + (size_t)ci * 128 * 128;
      epi(acc, [&](int m, int n, float v) { CB[m * 128 + n] = f2bf(v); });
    }
  }
}

DI void ssd_unit(const Params& p, int l, int unit) {
  const int tid = TID(), lane = tid & 63, w = __builtin_amdgcn_readfirstlane(tid >> 6), h = lane >> 5, c = lane & 31;
  int dir, head, nc, chunk0, sidx; bool lat;
  if (unit < 128) { lat = true; sidx = unit >> 5; dir = (unit >> 4) & 1; head = unit & 15; nc = 32; chunk0 = 32 + sidx * 32; }
  else { const int u = unit - 128; lat = false; sidx = u >> 5; dir = (u >> 4) & 1; head = u & 15; nc = 2; chunk0 = sidx * 2; }
  const int g = head >> 3;
  const float Dk = INP(p, I_SD)[(l * 2 + dir) * 16 + head];
  u16* sXT = (u16*)smem; u16* sXS = sXT + 64 * 136; u16* sHS = sXS + 64 * 136;
  float* cum = (float*)(sHS + 64 * 136); float* dtv = cum + 128; float* ecum = dtv + 128; float* dtr = ecum + 128;
  const u16* XT = (const u16*)(WSP(p) + WS_XT); const u16* BCP = (const u16*)(WSP(p) + WS_BCP); const u16* BT = (const u16*)(WSP(p) + WS_BT);
  const u16* CB = (const u16*)(WSP(p) + WS_CB); const float* CUMS = (const float*)(WSP(p) + WS_CUMS);
  u16* Y = (u16*)(WSP(p) + WS_ACT) + (dir ? C_YB : C_YF);
  f32x16 S[2];
  if (lat) {
    const float* st = INP(p, dir ? I_STB : I_STF) + ((size_t)((sidx * 4 + l) * 16 + head) * 64) * 128;
#pragma unroll
    for (int mt = 0; mt < 2; ++mt)
#pragma unroll
      for (int r = 0; r < 16; ++r) S[mt][r] = st[(size_t)(32 * mt + crow(r, h)) * 128 + 32 * w + c];
  } else {
#pragma unroll
    for (int mt = 0; mt < 2; ++mt)
#pragma unroll
      for (int r = 0; r < 16; ++r) S[mt][r] = 0.f;
  }
  __syncthreads();
#pragma unroll
  for (int mt = 0; mt < 2; ++mt)
#pragma unroll
    for (int r = 0; r < 16; ++r) sHS[(32 * mt + crow(r, h)) * 136 + 32 * w + c] = f2bf(S[mt][r]);
  const int i = 32 * w + c;
  const int ks_lo = dir ? 2 * w : 0, ks_hi = dir ? 8 : 2 * w + 2;
  const int pr0 = tid >> 4, j0 = (tid & 15) * 8;

  for (int step = 0; step < nc; ++step) {
    const int chunk = chunk0 + (dir ? nc - 1 - step : step);
    const int t0 = chunk * 128;
    const float* cs = CUMS + ((size_t)(chunk * 2 + dir) * 16 + head) * 768;
    u32x4 xr[4];
    const u16* xsrc = XT + ((size_t)chunk * 1024 + head * 64) * 128;
#pragma unroll
    for (int q = 0; q < 4; ++q) xr[q] = *(const u32x4*)(xsrc + (size_t)(pr0 + 16 * q) * 128 + j0);
    const f4 e1lo = *(const f4*)(cs + 256 + j0), e1hi = *(const f4*)(cs + 256 + j0 + 4);
    float t_cum = 0.f, t_dt = 0.f, t_ec = 0.f;
    float t_dr = 0.f;
    if (tid < 128) { t_cum = cs[tid]; t_dt = cs[128 + tid]; t_ec = cs[384 + tid]; t_dr = cs[640 + tid]; }
    const float dec = cs[512];
    float cref8[8], span8[8];
#pragma unroll
    for (int ks = 0; ks < 8; ++ks) { cref8[ks] = cs[520 + ks]; span8[ks] = cs[528 + ks]; }
    const u16* crowp = BCP + (size_t)(t0 + i) * 512 + 256 + g * 128 + 8 * h;
    const u16* cbrow = CB + ((size_t)(chunk * 2 + g) * 128 + i) * 128 + 8 * h;
    const u16* btrow = BT + ((size_t)chunk * 256 + g * 128 + 32 * w + c) * 128 + 8 * h;
    bf16x8 cf[8], btf[8]; u32x4 cbf[8];
#pragma unroll
    for (int ks = 0; ks < 8; ++ks) cf[ks] = *(const bf16x8*)(crowp + ks * 16);
#pragma unroll
    for (int ks = 0; ks < 8; ++ks) { u32x4 z = {0u, 0u, 0u, 0u}; cbf[ks] = (ks >= ks_lo && ks < ks_hi) ? *(const u32x4*)(cbrow + ks * 16) : z; }
#pragma unroll
    for (int ks = 0; ks < 8; ++ks) btf[ks] = *(const bf16x8*)(btrow + ks * 16);
    __builtin_amdgcn_sched_barrier(0);
    if (tid < 128) { cum[tid] = t_cum; dtv[tid] = t_dt; ecum[tid] = t_ec; dtr[tid] = t_dr; }
    {
      const float e1v[8] = {e1lo[0], e1lo[1], e1lo[2], e1lo[3], e1hi[0], e1hi[1], e1hi[2], e1hi[3]};
#pragma unroll
      for (int q = 0; q < 4; ++q) {
        const int pr = pr0 + 16 * q;
        *(u32x4*)(sXT + pr * 136 + j0) = xr[q];
        float f[8]; unpack8(xr[q], f);
#pragma unroll
        for (int e = 0; e < 8; ++e) f[e] *= e1v[e];
        *(u32x4*)(sXS + pr * 136 + j0) = pack8(f);
      }
    }
    __syncthreads();
    f32x16 Y1[2];
#pragma unroll
    for (int nt = 0; nt < 2; ++nt)
#pragma unroll
      for (int r = 0; r < 16; ++r) Y1[nt][r] = 0.f;
#pragma unroll
    for (int ks = 0; ks < 8; ++ks) {
#pragma unroll
      for (int nt = 0; nt < 2; ++nt) {
        const bf16x8 bfv = *(const bf16x8*)(sHS + (32 * nt + c) * 136 + ks * 16 + 8 * h);
        Y1[nt] = MFMA(cf[ks], bfv, Y1[nt]);
      }
    }
#pragma unroll
    for (int nt = 0; nt < 2; ++nt)
#pragma unroll
      for (int r = 0; r < 16; ++r) Y1[nt][r] *= ecum[32 * w + crow(r, h)];
    const float ci_ = cum[i];
#pragma unroll
    for (int ks = 0; ks < 8; ++ks) {
      if (ks >= ks_lo && ks < ks_hi) {
        float f[8]; unpack8(cbf[ks], f);
        if (span8[ks] <= 40.f) {
          const float rowf = __expf(fminf(ci_ - cref8[ks], 80.f));
#pragma unroll
          for (int e = 0; e < 8; ++e) {
            const int j = ks * 16 + 8 * h + e;
            const bool ok = dir ? (j >= i) : (j <= i);
            f[e] = ok ? f[e] * rowf * dtv[j] : 0.f;
          }
        } else {
#pragma unroll
          for (int e = 0; e < 8; ++e) {
            const int j = ks * 16 + 8 * h + e;
            const bool ok = dir ? (j >= i) : (j <= i);
            f[e] = ok ? f[e] * __expf(fminf(ci_ - cum[j], 0.f)) * dtr[j] : 0.f;
          }
        }
        const bf16x8 af = __builtin_bit_cast(bf16x8, pack8(f));
#pragma unroll
        for (int nt = 0; nt < 2; ++nt) {
          const bf16x8 bfv = *(const bf16x8*)(sXT + (32 * nt + c) * 136 + ks * 16 + 8 * h);
          Y1[nt] = MFMA(af, bfv, Y1[nt]);
        }
      }
    }
#pragma unroll
    for (int nt = 0; nt < 2; ++nt)
#pragma unroll
      for (int r = 0; r < 16; ++r) {
        const int ir = 32 * w + crow(r, h), pc = 32 * nt + c;
        const float y = Y1[nt][r] + Dk * bf2f(sXT[pc * 136 + ir]);
        Y[(size_t)(t0 + ir) * LDA + head * 64 + pc] = f2bf(y);
      }
#pragma unroll
    for (int mt = 0; mt < 2; ++mt)
#pragma unroll
      for (int r = 0; r < 16; ++r) S[mt][r] *= dec;
#pragma unroll
    for (int ks = 0; ks < 8; ++ks) {
#pragma unroll
      for (int mt = 0; mt < 2; ++mt) {
        const bf16x8 af = *(const bf16x8*)(sXS + (32 * mt + c) * 136 + ks * 16 + 8 * h);
        S[mt] = MFMA(af, btf[ks], S[mt]);
      }
    }
    __syncthreads();
#pragma unroll
    for (int mt = 0; mt < 2; ++mt)
#pragma unroll
      for (int r = 0; r < 16; ++r) sHS[(32 * mt + crow(r, h)) * 136 + 32 * w + c] = f2bf(S[mt][r]);
  }
  if (!lat) {
    float* o = OUTP(p) + (dir ? O_SB : O_SF) + ((size_t)((sidx * 4 + l) * 16 + head) * 64) * 128;
#pragma unroll
    for (int mt = 0; mt < 2; ++mt)
#pragma unroll
      for (int r = 0; r < 16; ++r) o[(size_t)(32 * mt + crow(r, h)) * 128 + 32 * w + c] = S[mt][r];
  }
  __syncthreads();
}

DI void attn_item(const Params& p, int l, int item) {
  const int tid = TID(), lane = tid & 63, w = __builtin_amdgcn_readfirstlane(tid >> 6), h = lane >> 5, c = lane & 31;
  int hh, t0, Lk, krow0, pos0; size_t vbase; bool lat;
  if (item < 1024) { const int b = item >> 8; hh = (item >> 5) & 7; const int qb = item & 31; lat = true; t0 = TC + b * 4096 + qb * 128; Lk = LKL; krow0 = b * LKL; vbase = (size_t)b * 512 * LKL; pos0 = qb * 128; }
  else { const int it = item - 1024; const int s = it >> 4; hh = (it >> 1) & 7; const int qb = it & 1; lat = false; t0 = s * 256 + qb * 128; Lk = 256; krow0 = KROW_CTX + s * 256; vbase = (size_t)4 * 512 * LKL + (size_t)s * 512 * 256; pos0 = 0; }
  const u16* Q = (const u16*)(WSP(p) + WS_Q); const u16* KN = (const u16*)(WSP(p) + WS_KN); const u16* KRA = (const u16*)(WSP(p) + WS_KR);
  const u16* VT = (const u16*)(WSP(p) + WS_VT) + vbase + (size_t)hh * 64 * Lk;
  u16* YC = (u16*)(WSP(p) + WS_YC);
  u16* sK = (u16*)smem;
  u16* sV = sK + 2 * 64 * 104;
  bf16x8 qf[6];
  {
    const int tq = t0 + 32 * w + c;
    const u16* qrow = Q + (size_t)tq * 768 + hh * 96 + 8 * h;
    float f[6][8];
#pragma unroll
    for (int s = 0; s < 6; ++s) unpack8(*(const u32x4*)(qrow + 16 * s), f[s]);
    if (lat) {
      const int pos = pos0 + 32 * w + c;
#pragma unroll
      for (int e = 0; e < 8; ++e) {
        const int ii = 8 * h + e;
        const float pp = (ii < 8) ? (float)(pos >> 6) : (float)(pos & 63);
        const float inv = exp2f(-(float)(ii & 7) * (13.287712379549449f / 8.f));
        const float ang = pp * inv;
        const float cs = cosf(ang), sn = sinf(ang);
        const float x1 = f[4][e], x2 = f[5][e];
        f[4][e] = x1 * cs - x2 * sn; f[5][e] = x1 * sn + x2 * cs;
      }
    }
    const float sc = 0.10206207261596575f * 1.4426950408889634f;
#pragma unroll
    for (int s = 0; s < 6; ++s) {
#pragma unroll
      for (int e = 0; e < 8; ++e) f[s][e] *= sc;
      qf[s] = __builtin_bit_cast(bf16x8, pack8(f[s]));
    }
  }
  f32x16 O[2];
#pragma unroll
  for (int vt = 0; vt < 2; ++vt)
#pragma unroll
    for (int r = 0; r < 16; ++r) O[vt][r] = 0.f;
  float m_run = -1e30f, l_run = 0.f;
  const int ntile = Lk >> 6;
  u32x4 rk[3], rv[2];
  auto gload = [&](int kt) {
    const int key0 = kt * 64;
#pragma unroll
    for (int q = 0; q < 3; ++q) {
      const int id = tid + 256 * q, key = id / 12, cc = id - key * 12;
      const size_t kr = (size_t)(krow0 + key0 + key);
      rk[q] = cc < 8 ? *(const u32x4*)(KN + kr * 512 + hh * 64 + cc * 8) : *(const u32x4*)(KRA + kr * 32 + (cc - 8) * 8);
    }
#pragma unroll
    for (int q = 0; q < 2; ++q) {
      const int id = tid + 256 * q, v = id >> 3, cc = id & 7;
      rv[q] = *(const u32x4*)(VT + (size_t)v * Lk + key0 + cc * 8);
    }
  };
  auto sstore = [&](int buf) {
#pragma unroll
    for (int q = 0; q < 3; ++q) {
      const int id = tid + 256 * q, key = id / 12, cc = id - key * 12;
      *(u32x4*)(sK + buf * 64 * 104 + key * 104 + cc * 8) = rk[q];
    }
#pragma unroll
    for (int q = 0; q < 2; ++q) {
      const int id = tid + 256 * q, v = id >> 3, cc = id & 7;
      u16* d = sV + buf * 64 * 68 + v * 68 + cc * 8;
      u32x2 lo = {rv[q][0], rv[q][1]}, hi = {rv[q][2], rv[q][3]};
      *(u32x2*)d = lo; *(u32x2*)(d + 4) = hi;
    }
  };
  gload(0);
  __syncthreads();
  sstore(0);
  __syncthreads();
  for (int kt = 0; kt < ntile; ++kt) {
    const int cur = kt & 1;
    if (kt + 1 < ntile) gload(kt + 1);
    f32x16 Sx[2];
#pragma unroll
    for (int k2 = 0; k2 < 2; ++k2) {
#pragma unroll
      for (int r = 0; r < 16; ++r) Sx[k2][r] = 0.f;
      const u16* kp = sK + cur * 64 * 104 + (32 * k2 + c) * 104 + 8 * h;
#pragma unroll
      for (int s = 0; s < 6; ++s) Sx[k2] = MFMA(*(const bf16x8*)(kp + 16 * s), qf[s], Sx[k2]);
    }
    float mx = Sx[0][0];
#pragma unroll
    for (int k2 = 0; k2 < 2; ++k2)
#pragma unroll
      for (int r = 0; r < 16; ++r) mx = fmaxf(mx, Sx[k2][r]);
    mx = fmaxf(mx, __shfl_xor(mx, 32));
    const float m_new = fmaxf(m_run, mx);
    const float alpha = __builtin_amdgcn_exp2f(m_run - m_new);
    m_run = m_new;
    float ls = 0.f;
#pragma unroll
    for (int k2 = 0; k2 < 2; ++k2)
#pragma unroll
      for (int r = 0; r < 16; ++r) { const float pv = __builtin_amdgcn_exp2f(Sx[k2][r] - m_new); Sx[k2][r] = pv; ls += pv; }
    l_run = l_run * alpha + ls;
#pragma unroll
    for (int vt = 0; vt < 2; ++vt)
#pragma unroll
      for (int r = 0; r < 16; ++r) O[vt][r] *= alpha;
#pragma unroll
    for (int k2 = 0; k2 < 2; ++k2)
#pragma unroll
      for (int s2 = 0; s2 < 2; ++s2) {
        u32x4 pp;
        pp[0] = pk2(Sx[k2][8 * s2 + 0], Sx[k2][8 * s2 + 1]); pp[1] = pk2(Sx[k2][8 * s2 + 2], Sx[k2][8 * s2 + 3]);
        pp[2] = pk2(Sx[k2][8 * s2 + 4], Sx[k2][8 * s2 + 5]); pp[3] = pk2(Sx[k2][8 * s2 + 6], Sx[k2][8 * s2 + 7]);
        const bf16x8 pf = __builtin_bit_cast(bf16x8, pp);
#pragma unroll
        for (int vt = 0; vt < 2; ++vt) {
          const u16* vp = sV + cur * 64 * 68 + (32 * vt + c) * 68 + 32 * k2 + 16 * s2 + 4 * h;
          const u32x2 lo = *(const u32x2*)vp, hi = *(const u32x2*)(vp + 8);
          u32x4 vv = {lo[0], lo[1], hi[0], hi[1]};
          O[vt] = MFMA(__builtin_bit_cast(bf16x8, vv), pf, O[vt]);
        }
      }
    if (kt + 1 < ntile) sstore(cur ^ 1);
    __syncthreads();
  }
  const float lt = l_run + __shfl_xor(l_run, 32);
  const float invl = 1.f / lt;
  const int tq = t0 + 32 * w + c;
#pragma unroll
  for (int vt = 0; vt < 2; ++vt)
#pragma unroll
    for (int g = 0; g < 4; ++g) {
      u32x2 pk; pk[0] = pk2(O[vt][4 * g] * invl, O[vt][4 * g + 1] * invl); pk[1] = pk2(O[vt][4 * g + 2] * invl, O[vt][4 * g + 3] * invl);
      *(u32x2*)(YC + (size_t)tq * 512 + hh * 64 + 32 * vt + 8 * g + 4 * h) = pk;
    }
}

DI void l5_phase(const Params& p, int l, int rep = 0) {
  u32* ctr = (u32*)(WSP(p) + WS_CTR) + l + 8 * rep;
  int* sitem = (int*)(smem + 73728 - 16);
  constexpr int NITEMS = 128 + 1024 + 256 + 512;
  while (true) {
    __syncthreads();
    if (TID() == 0) *sitem = (int)atomicAdd(ctr, 1u);
    __syncthreads();
    const int it = *sitem;
    if (it >= NITEMS) break;
    if (it < 128) ssd_unit(p, l, it);
    else if (it < 128 + 1280) attn_item(p, l, it - 128);
    else ssd_unit(p, l, it - 1280);
  }
}

DI void l5b_phase(const Params& p, int l) {
  u16* ACT = (u16*)(WSP(p) + WS_ACT);
  float* RB = (float*)(WSP(p) + WS_RB);
  const int lane = TID() & 63, gw = BID() * 4 + (TID() >> 6), nwv = gridDim.x * 4;
  for (int t = gw; t < T; t += nwv) {
    u16* row = ACT + (size_t)t * LDA;
    float ss = 0.f;
#pragma unroll
    for (int q = 0; q < 2; ++q) {
      const int c8 = (lane + 64 * q) * 8;
      float yf[8], yb[8], z[8], o[8];
      unpack8(*(const u32x4*)(row + C_YF + c8), yf); unpack8(*(const u32x4*)(row + C_YB + c8), yb); unpack8(*(const u32x4*)(row + C_Z + c8), z);
#pragma unroll
      for (int e = 0; e < 8; ++e) { o[e] = (yf[e] + yb[e]) * silu_f(z[e]); ss += o[e] * o[e]; }
      *(u32x4*)(row + C_YF + c8) = pack8(o);
    }
    ss = wave_sum(ss);
    if (lane == 0) RB[t] = rsqrtf(ss * (1.f / 1024.f) + EPS);
  }
}

DI int gate_col(int n) { return n < 2048 ? n : 3584 + (n - 2048); }
DI void l6a_phase(const Params& p, int l, int& nbar) {
  constexpr int NT = 24;
  TILE_LOOP(160 * NT) {
    group_sync(p, nbar);
    if (idx >= 160 * NT) continue;
    int mt, nt; decode_tile(idx, NT, mt, nt);
    const u16* W = (const u16*)(WSP(p) + WS_W) + W_GATE;
    const u16* H = (const u16*)(WSP(p) + WS_H);
    u16* ACT = (u16*)(WSP(p) + WS_ACT);
    f32x16 acc[4];
#pragma unroll
    for (int j = 0; j < 4; ++j)
#pragma unroll
      for (int r = 0; r < 16; ++r) acc[j][r] = 0.f;
    gemm_tile_wf4(W, 1024, nt * 128, H + (size_t)mt * 128 * 1024, 1024, acc);
    const int m0 = mt * 128, gc0 = gate_col(nt * 128);
    stage_bf16_w4([&](int j, int r) { return sigmoid_f(acc[j][r]); });
    copy_out_bf16<128>(ACT + (size_t)m0 * LDA + gc0, LDA, 128);
  }
}
DI void l6b_phase(const Params& p, int l, int& nbar) {
  TILE_LOOP(160 * 8) {
    group_sync(p, nbar);
    if (idx >= 160 * 8) continue;
    int mt, nt; decode_tile(idx, 8, mt, nt);
    const int m0 = mt * 128, n0 = nt * 128;
    u32 Mp[4][8];
#pragma unroll
    for (int j = 0; j < 4; ++j)
#pragma unroll
      for (int r = 0; r < 8; ++r) Mp[j][r] = 0u;
#pragma unroll 1
    for (int br = 0; br < 3; ++br) {
      const u16* W = (const u16*)(WSP(p) + WS_W);
      const u16* ACT = (const u16*)(WSP(p) + WS_ACT);
      f32x16 acc[4];
#pragma unroll
      for (int j = 0; j < 4; ++j)
#pragma unroll
        for (int r = 0; r < 16; ++r) acc[j][r] = 0.f;
      const u16* Ab; const u16* Wb; int ldab, Kb;
      if (br == 0) { Ab = (const u16*)(WSP(p) + WS_YA) + (size_t)m0 * 512; ldab = 512; Wb = W + W_A; Kb = 512; }
      else if (br == 1) { Ab = ACT + (size_t)m0 * LDA + C_YF; ldab = LDA; Wb = W + W_B; Kb = 1024; }
      else { Ab = (const u16*)(WSP(p) + WS_YC) + (size_t)m0 * 512; ldab = 512; Wb = W + W_C; Kb = 512; }
      gemm_tile_wf4(Wb, Kb, n0, Ab, ldab, acc);
      const float* RB = (const float*)(WSP(p) + WS_RB);
      const int tid3 = TID(), lane3 = tid3 & 63, w3 = tid3 >> 6;
      const int h = lane3 >> 5, c = lane3 & 31;
      const int gc0 = gate_col(br * 1024 + n0);
      u16* sG = (u16*)smem;
#pragma unroll
      for (int q = 0; q < 8; ++q) {
        const int id = tid3 + 256 * q, row = id >> 4, cc = id & 15;
        *(u32x4*)(sG + row * 136 + cc * 8) = *(const u32x4*)(ACT + (size_t)(m0 + row) * LDA + gc0 + cc * 8);
      }
      __syncthreads();
#pragma unroll
      for (int j = 0; j < 4; ++j) {
        const int ml = j * 32 + c;
        const float rb = (br == 1) ? RB[m0 + ml] : 1.f;
#pragma unroll
        for (int g = 0; g < 4; ++g) {
          const u32x2 gv = *(const u32x2*)(sG + ml * 136 + w3 * 32 + 8 * g + 4 * h);
          const float v0 = acc[j][4 * g] * rb, v1 = acc[j][4 * g + 1] * rb, v2 = acc[j][4 * g + 2] * rb, v3 = acc[j][4 * g + 3] * rb;
          Mp[j][2 * g] = pk2(bflo(Mp[j][2 * g]) + bflo(gv[0]) * v0, bfhi(Mp[j][2 * g]) + bfhi(gv[0]) * v1);
          Mp[j][2 * g + 1] = pk2(bflo(Mp[j][2 * g + 1]) + bflo(gv[1]) * v2, bfhi(Mp[j][2 * g + 1]) + bfhi(gv[1]) * v3);
        }
      }
    }
    {
      u16* MG = (u16*)(WSP(p) + WS_XT);
      u16* sC = (u16*)smem;
      const int tid4 = TID(), lane4 = tid4 & 63, w4 = tid4 >> 6;
      const int h = lane4 >> 5, c = lane4 & 31;
      __syncthreads();
#pragma unroll
      for (int j = 0; j < 4; ++j)
#pragma unroll
        for (int g = 0; g < 4; ++g) {
          u32x2 pk; pk[0] = Mp[j][2 * g]; pk[1] = Mp[j][2 * g + 1];
          *(u32x2*)(sC + (j * 32 + c) * 136 + w4 * 32 + 8 * g + 4 * h) = pk;
        }
      __syncthreads();
      copy_out_bf16<128>(MG + (size_t)m0 * 1024 + n0, 1024, 128);
    }
  }
}

DI void resid_gemm_phase(const Params& p, int l, const u16* A, int lda, const u16* Wm, int K, int gidx, int& nbar) {
  float* X = OUTP(p);
  const float* MOD = (const float*)(WSP(p) + WS_MOD) + (size_t)l * 5 * 6144 + gidx * 1024;
  constexpr int NFULL = 1024, NITEM = 1024 + 512;
  TILE_LOOP(NITEM) {
    group_sync(p, nbar);
    if (idx >= NITEM) continue;
    const bool split = idx >= NFULL;
    const int tile = split ? NFULL + ((idx - NFULL) >> 1) : idx;
    const int half = split ? ((idx - NFULL) & 1) : 0;
    const int Kp = split ? (K >> 1) : K;
    int mt, nt; decode_tile(tile, 8, mt, nt);
    const int m0 = mt * 128, n0 = nt * 128;
    f32x16 acc[4];
#pragma unroll
    for (int j = 0; j < 4; ++j)
#pragma unroll
      for (int r = 0; r < 16; ++r) acc[j][r] = 0.f;
    gemm_tile_wf4(Wm, K, n0, A + (size_t)m0 * lda + half * Kp, lda, acc, Kp, (half * Kp) >> 4);
    const float* gt = MOD + tile_cb(mt) * 6144 + n0;
    stage_f32_w4(acc);
    {
      const float* sC = (const float*)smem;
      const int tid = TID(), cc = tid & 31;
      const f4 g4 = *(const f4*)(gt + cc * 4);
#pragma unroll 4
      for (int q = 0; q < 16; ++q) {
        const int row = (tid >> 5) + 8 * q;
        const f4 v = *(const f4*)(sC + row * 132 + cc * 4);
        float* xp = X + (size_t)(m0 + row) * 1024 + n0 + cc * 4;
        if (!split) { f4 x = *(const f4*)xp; x[0] += g4[0] * v[0]; x[1] += g4[1] * v[1]; x[2] += g4[2] * v[2]; x[3] += g4[3] * v[3]; *(f4*)xp = x; }
        else { atomicAdd(xp, g4[0] * v[0]); atomicAdd(xp + 1, g4[1] * v[1]); atomicAdd(xp + 2, g4[2] * v[2]); atomicAdd(xp + 3, g4[3] * v[3]); }
      }
    }
  }
}

template <int MODE = 0>
DI void l9_phase(const Params& p, int l, int& nbar) {
  const u16* W = (const u16*)(WSP(p) + WS_W) + W_F13;
  const u16* H = (const u16*)(WSP(p) + WS_H);
  u16* ACT = (u16*)(WSP(p) + WS_ACT);
  const int lane = TID() & 63, w = TID() >> 6, wm = w >> 1, wn = w & 1, h = lane >> 5, c = lane & 31;
  constexpr int NT = 44;
  TILE_LOOP(160 * NT) {
    group_sync(p, nbar);
    if (idx >= 160 * NT) continue;
    int mt, nt; decode_tile(idx, NT, mt, nt);
    f32x16 acc[4];
#pragma unroll
    for (int j = 0; j < 4; ++j)
#pragma unroll
      for (int r = 0; r < 16; ++r) acc[j][r] = 0.f;
    gemm_tile_wf4(W, 1024, nt * 128, H + (size_t)mt * 128 * 1024, 1024, acc);
    stage_bf16_w4u([&](int j, int r) { return silu_f(acc[j][r]) * acc[j][r + 8]; });
    if (MODE == 0) copy_out_bf16<64>(ACT + (size_t)mt * 128 * LDA + C_U + nt * 64, LDA, 64);
  }
}

DI void final_phase(const Params& p) {
  float* X = OUTP(p);
  const float* nw = INP(p, I_FNW);
  const int lane = TID() & 63, gw = BID() * 4 + (TID() >> 6), nwv = gridDim.x * 4;
  for (int t = gw; t < T; t += nwv) {
    f4* xr = (f4*)(X + (size_t)t * 1024) + lane;
    f4 v[4]; float s = 0.f;
#pragma unroll
    for (int j = 0; j < 4; ++j) { v[j] = xr[64 * j]; s += v[j][0] * v[j][0] + v[j][1] * v[j][1] + v[j][2] * v[j][2] + v[j][3] * v[j][3]; }
    const float rstd = rsqrtf(wave_sum(s) * (1.f / 1024.f) + EPS);
#pragma unroll
    for (int j = 0; j < 4; ++j) {
      const f4 wv = *(const f4*)(nw + 4 * lane + 256 * j);
      f4 o; o[0] = v[j][0] * rstd * wv[0]; o[1] = v[j][1] * rstd * wv[1]; o[2] = v[j][2] * rstd * wv[2]; o[3] = v[j][3] * rstd * wv[3];
      xr[64 * j] = o;
    }
  }
}

constexpr int NPH_LAYER = 11;
constexpr int NPHASE = 1 + NLAYER * NPH_LAYER + 1;

DI void run_phase(const Params& p, int ph) {
  int nbar = 0;
  if (ph == 0) { pre_phase(p); return; }
  if (ph == NPHASE - 1) { final_phase(p); return; }
  const int l = (ph - 1) / NPH_LAYER, s = (ph - 1) % NPH_LAYER;
  const u16* W = (const u16*)(WSP(p) + WS_W);
  const u16* ACT = (const u16*)(WSP(p) + WS_ACT);
  switch (s) {
    case 0: l1_phase(p, l); break;
    case 1: l2_phase(p, l, nbar); break;
    case 2: l3_phase(p, l); break;
    case 3: l4_phase(p, l, nbar); break;
    case 4: l5_phase(p, l); break;
    case 5: l5b_phase(p, l); break;
    case 6: l6a_phase(p, l, nbar); l6b_phase(p, l, nbar); break;
    case 7: resid_gemm_phase(p, l, (const u16*)(WSP(p) + WS_XT), 1024, W + W_O, 1024, 2, nbar); break;
    case 8: norm_phase(p, l, 1); break;
    case 9: l9_phase(p, l, nbar); break;
    case 10: resid_gemm_phase(p, l, ACT + C_U, LDA, W + W_F2, FF, 5, nbar); break;
  }
}

__global__ void __launch_bounds__(256, 2) fwd_kernel(Params p) {
#if MULTI
  run_phase(p, p.ph_lo);
#else
  cg::grid_group grid = cg::this_grid();
  if (threadIdx.x == 0) xb_words = make_uint4(0u, 0u, 0u, 0u);
  __syncthreads();
  if (threadIdx.x == 0) (void)xb_add(&((unsigned*)(WSP(p) + WS_BAR))[XB_XCNT(xb_xcc_id())], 1u);
  if (p.ph_lo < 0) grid.sync();
  int nbar = 0;
  pre_phase(p); gsync(p);
#pragma unroll 1
  for (int l = 0; l < NLAYER; ++l) {
    l1_phase(p, l); gsync(p);
    if (PROBE_DUP == 1) { l1_phase(p, l); gsync(p); }
    l2_phase(p, l, nbar); gsync(p);
    if (PROBE_DUP == 2) { l2_phase(p, l, nbar); gsync(p); }
    l3_phase(p, l); l3d_phase(p, l); gsync(p);
    if (PROBE_DUP == 3) { l3_phase(p, l); gsync(p); }
    l4_phase(p, l, nbar); gsync(p);
    if (PROBE_DUP == 4) { l4_phase(p, l, nbar); gsync(p); }
    l5_phase(p, l); gsync(p);
    if (PROBE_DUP == 5) { l5_phase(p, l, 1); gsync(p); }
    l5b_phase(p, l); gsync(p);
    l6a_phase(p, l, nbar); gsync(p);
    l6b_phase(p, l, nbar); gsync(p);
    resid_gemm_phase(p, l, (const u16*)(WSP(p) + WS_XT), 1024, (const u16*)(WSP(p) + WS_W) + W_O, 1024, 2, nbar); gsync(p);
    norm_phase(p, l, 1); gsync(p);
    l9_phase(p, l, nbar); gsync(p);
    if (PROBE_DUP == 9) { l9_phase<GEMM_MODE_PROBE>(p, l, nbar); gsync(p); }
    resid_gemm_phase(p, l, (const u16*)(WSP(p) + WS_ACT) + C_U, LDA, (const u16*)(WSP(p) + WS_W) + W_F2, FF, 5, nbar); gsync(p);
  }
  final_phase(p);
#endif
}

extern "C" void kernel_launch(void* const* d_in, const int* in_sizes, int n_in, void* d_out, int out_size, void* d_ws, size_t ws_size,
                              hipStream_t stream) {
  static int grid_blocks = 0;
  if (!grid_blocks) {
    int dev = 0, cus = 0, per_cu = 0;
    hipGetDevice(&dev);
    hipDeviceGetAttribute(&cus, hipDeviceAttributeMultiprocessorCount, dev);
    hipOccupancyMaxActiveBlocksPerMultiprocessor(&per_cu, fwd_kernel, 256, 0);
    per_cu = 2;
    grid_blocks = cus * per_cu;
    if (ws_size < WS_END || n_in != 32) { fprintf(stderr, "kernel_launch: ws too small (%zu < %zu) or n_in %d\n", ws_size, (size_t)WS_END, n_in); grid_blocks = -1; }
  }
  if (grid_blocks < 0) return;
  Params p{};
  for (int i = 0; i < 32; ++i) p.in[i] = (const float*)d_in[i];
  p.in[32] = (const float*)d_out;
  p.in[33] = (const float*)d_ws;
#if MULTI
  for (int ph = 0; ph < NPHASE; ++ph) {
    p.ph_lo = ph; p.ph_hi = ph + 1;
    hipLaunchKernelGGL(fwd_kernel, dim3(grid_blocks), dim3(256), 0, stream, p);
  }
#else
  p.ph_lo = 0; p.ph_hi = NPHASE;
  (void)hipMemsetAsync((char*)d_ws + WS_BAR, 0, 16384, stream);
  void* args[] = {&p};
  hipError_t e = hipLaunchCooperativeKernel((void*)fwd_kernel, dim3(grid_blocks), dim3(256), args, 0, stream);
  if (e != hipSuccess) fprintf(stderr, "cooperative launch failed: %s (grid %d)\n", hipGetErrorString(e), grid_blocks);
#endif
}
```

```cpp
#include <hip/hip_runtime.h>
#include <hip/hip_cooperative_groups.h>
#include <cstdio>
namespace cg = cooperative_groups;

#ifndef PROBE_DUP
#define PROBE_DUP 0
#endif
#ifndef USE_GSYNC
#define USE_GSYNC 0
#endif
#ifndef GEMM_MODE_PROBE
#define GEMM_MODE_PROBE 1
#endif
#ifndef MULTI
#define MULTI 0
#endif

#define DI __device__ __forceinline__
typedef unsigned short u16;
typedef unsigned int u32;
using bf16x8 = __attribute__((ext_vector_type(8))) short;
using f32x16 = __attribute__((ext_vector_type(16))) float;
using u32x4 = __attribute__((ext_vector_type(4))) unsigned;
using u32x2 = __attribute__((ext_vector_type(2))) unsigned;
using f4 = __attribute__((ext_vector_type(4))) float;
typedef __bf16 bf2_t __attribute__((ext_vector_type(2)));
typedef float f2_t __attribute__((ext_vector_type(2)));
#define MFMA(a, b, c) __builtin_amdgcn_mfma_f32_32x32x16_bf16((a), (b), (c), 0, 0, 0)

constexpr int D = 1024, T = 20480, TC = 4096, NLAYER = 4;
constexpr int NPROJ = 4656, INC = 7728, FF = 2816;
constexpr int LDA = 4672;
constexpr int C_AX = 0, C_AB = 512, C_AC = 1024, C_Z = 1536, C_XBC = 2560, C_DT = 4096, C_CQ = 4112, C_CKV = 4368, C_KR = 4624;
constexpr int C_YF = C_XBC, C_YB = 0, C_MERGED = 0, C_U = 0;
constexpr int NKROW = 22528, KROW_CTX = 18432, LKL = 4608;
constexpr float EPS = 1e-6f;

constexpr size_t W_IN = 0;
constexpr size_t W_GATE = W_IN + (size_t)4736 * 1024;
constexpr size_t W_A = W_GATE + (size_t)3072 * 1024;
constexpr size_t W_B = W_A + 1024 * 512;
constexpr size_t W_UQ = W_B + 1024 * 1024;
constexpr size_t W_UKV = W_UQ + 768 * 256;
constexpr size_t W_C = W_UKV + 1024 * 256;
constexpr size_t W_O = W_C + 1024 * 512;
constexpr size_t W_F13 = W_O + 1024 * 1024;
constexpr size_t W_F2 = W_F13 + (size_t)2 * FF * 1024;
constexpr size_t W_END = W_F2 + (size_t)1024 * FF;

constexpr size_t al256(size_t x) { return (x + 255) & ~(size_t)255; }
constexpr size_t WS_W = 0;
constexpr size_t WS_ACT = al256(WS_W + W_END * 2);
constexpr size_t WS_H = al256(WS_ACT + (size_t)T * LDA * 2);
constexpr size_t WS_XT = al256(WS_H + (size_t)T * 1024 * 2);
constexpr size_t WS_BCP = al256(WS_XT + (size_t)T * 1024 * 2);
constexpr size_t WS_BT = al256(WS_BCP + (size_t)T * 512 * 2);
constexpr size_t WS_YA = al256(WS_BT + (size_t)160 * 256 * 128 * 2);
constexpr size_t WS_YC = al256(WS_YA + (size_t)T * 512 * 2);
constexpr size_t WS_Q = al256(WS_YC + (size_t)T * 512 * 2);
constexpr size_t WS_KN = al256(WS_Q + (size_t)T * 768 * 2);
constexpr size_t WS_VT = al256(WS_KN + (size_t)NKROW * 512 * 2);
constexpr size_t WS_KR = al256(WS_VT + (size_t)NKROW * 512 * 2);
constexpr size_t WS_CKVA = al256(WS_KR + (size_t)NKROW * 32 * 2);
constexpr size_t WS_CB = al256(WS_CKVA + (size_t)NKROW * 256 * 2);
constexpr size_t WS_DT = al256(WS_CB + (size_t)320 * 128 * 128 * 2);
constexpr size_t WS_RQ = al256(WS_DT + (size_t)T * 16 * 4);
constexpr size_t WS_RB = al256(WS_RQ + (size_t)T * 4);
constexpr size_t WS_MOD = al256(WS_RB + (size_t)T * 4);
constexpr size_t WS_CTR = al256(WS_MOD + (size_t)NLAYER * 5 * 6144 * 4);
constexpr size_t WS_CUMS = al256(WS_CTR + 4096);
constexpr size_t WS_BAR = al256(WS_CUMS + (size_t)160 * 2 * 16 * 768 * 4);
constexpr size_t WS_END = WS_BAR + 16384;

constexpr size_t O_CKV = 20971520, O_KR = 25165824, O_SF = 25690112, O_SB = 34078720;

struct Params {
  const float* in[34];
  int ph_lo, ph_hi;
};
enum { I_XP = 0, I_XS, I_C, I_CCKV, I_CKR, I_STF, I_STB, I_CCTX, I_WIN, I_ACW, I_WAO, I_SCW, I_SCB, I_ALOG, I_DTB, I_SD, I_SNW, I_WBO,
       I_QNW, I_WUQ, I_KVNW, I_WUKV, I_WCO, I_WO, I_WADA, I_BADA, I_N1, I_N2, I_F1, I_F3, I_F2, I_FNW };

DI int TID() { int t = threadIdx.x; asm volatile("" : "+v"(t)); return t; }
DI int BID() { int b = blockIdx.x; asm volatile("" : "+s"(b)); return b; }
DI const float* KARG(int i) {
  unsigned long long kp = (unsigned long long)__builtin_amdgcn_kernarg_segment_ptr();
  asm volatile("" : "+s"(kp));
  typedef __attribute__((address_space(4))) const unsigned long long* karg_ptr_t;
  typedef __attribute__((address_space(1))) const float* gptr_t;
  return (const float*)(gptr_t)(((karg_ptr_t)kp)[i]);
}
DI unsigned char* WSP(const Params& p) { return (unsigned char*)KARG(33); }
DI float* OUTP(const Params& p) { return (float*)KARG(32); }
DI const float* INP(const Params& p, int i) { return KARG(i); }
DI float bf2f(u16 v) { return __uint_as_float((u32)v << 16); }
DI float bflo(u32 v) { return __uint_as_float(v << 16); }
DI float bfhi(u32 v) { return __uint_as_float(v & 0xffff0000u); }
DI u32 pk2(float a, float b) { f2_t v = {a, b}; bf2_t r = __builtin_convertvector(v, bf2_t); return __builtin_bit_cast(u32, r); }
DI u16 f2bf(float a) { return (u16)(pk2(a, 0.f) & 0xffffu); }
DI float silu_f(float x) { return x / (1.f + __expf(-x)); }
DI float sigmoid_f(float x) { return 1.f / (1.f + __expf(-x)); }
DI float wave_sum(float v) {
#pragma unroll
  for (int o = 1; o < 64; o <<= 1) v += __shfl_xor(v, o);
  return v;
}
DI int crow(int r, int h) { return (r & 3) + 8 * (r >> 2) + 4 * h; }
DI int tile_cb(int mt) { return mt < 32 ? 0 : 1 + ((mt - 32) >> 5); }

__shared__ __attribute__((aligned(16))) unsigned char smem[73728];

template <int MODE = 0>
DI void gemm_tile(const u16* A, int lda, const u16* B, int ldb, int K, f32x16 (&acc)[2][2]) {
  u16* sA = (u16*)smem;
  u16* sB = sA + 2 * 128 * 72;
  const int tid = TID(), lane = tid & 63, w = tid >> 6, wm = w >> 1, wn = w & 1;
  const int lr = tid >> 3, lc = (tid & 7) * 8;
  const u16* ga = A + (size_t)lr * lda + lc;
  const u16* gb = B + (size_t)lr * ldb + lc;
  u32x4 ra[4], rb[4];
#pragma unroll
  for (int p = 0; p < 4; ++p) { ra[p] = *(const u32x4*)(ga + (size_t)(32 * p) * lda); rb[p] = *(const u32x4*)(gb + (size_t)(32 * p) * ldb); }
  __syncthreads();
#pragma unroll
  for (int p = 0; p < 4; ++p) { *(u32x4*)(sA + (lr + 32 * p) * 72 + lc) = ra[p]; *(u32x4*)(sB + (lr + 32 * p) * 72 + lc) = rb[p]; }
  __syncthreads();
  const int nk = K >> 6;
  const int fo_a = (wm * 64 + (lane & 31)) * 72 + (lane >> 5) * 8;
  const int fo_b = (wn * 64 + (lane & 31)) * 72 + (lane >> 5) * 8;
  for (int kt = 0; kt < nk; ++kt) {
    const int cur = kt & 1;
    if (kt + 1 < nk) {
      const int k0 = (kt + 1) * 64;
#pragma unroll
      for (int p = 0; p < 4; ++p) { ra[p] = *(const u32x4*)(ga + (size_t)(32 * p) * lda + k0); rb[p] = *(const u32x4*)(gb + (size_t)(32 * p) * ldb + k0); }
    }
    const u16* pa = sA + cur * 128 * 72 + fo_a;
    const u16* pb = sB + cur * 128 * 72 + fo_b;
#pragma unroll
    for (int ks = 0; ks < 4; ++ks) {
      bf16x8 a0 = *(const bf16x8*)(pa + ks * 16), a1 = *(const bf16x8*)(pa + 32 * 72 + ks * 16);
      bf16x8 b0 = *(const bf16x8*)(pb + ks * 16), b1 = *(const bf16x8*)(pb + 32 * 72 + ks * 16);
      acc[0][0] = MFMA(a0, b0, acc[0][0]); acc[0][1] = MFMA(a0, b1, acc[0][1]);
      acc[1][0] = MFMA(a1, b0, acc[1][0]); acc[1][1] = MFMA(a1, b1, acc[1][1]);
    }
    if (kt + 1 < nk) {
      u16* da = sA + (cur ^ 1) * 128 * 72; u16* db = sB + (cur ^ 1) * 128 * 72;
#pragma unroll
      for (int p = 0; p < 4; ++p) { *(u32x4*)(da + (lr + 32 * p) * 72 + lc) = ra[p]; *(u32x4*)(db + (lr + 32 * p) * 72 + lc) = rb[p]; }
    }
    __syncthreads();
  }
}

template <int MODE = 0>
DI void gemm_tile_wf(const u16* Wfm, int K, int nrow0, const u16* Act, int ldact, f32x16 (&acc)[2][2]) {
  u16* sB = (u16*)smem;
  const int tid = TID(), lane = tid & 63, w = tid >> 6, wm = w >> 1, wn = w & 1;
  const int lr = tid >> 3, lc = (tid & 7) * 8;
  const u16* gb = Act + (size_t)lr * ldact + lc;
  const size_t sb32 = (size_t)32 * ldact;
  const int kq = K >> 4;
  const u16* gw0 = Wfm + ((size_t)((nrow0 >> 5) + wm * 2) * kq) * 512 + lane * 8;
  const u16* gw1 = gw0 + (size_t)kq * 512;
  const int so = lr * 72 + lc;
  const int nk = K >> 6;
  u32x4 rb[4];
  bf16x8 wa[2][4], wb[2][4];
#pragma unroll
  for (int p = 0; p < 4; ++p) rb[p] = *(const u32x4*)(gb + p * sb32);
#pragma unroll
  for (int ks = 0; ks < 4; ++ks) { wa[0][ks] = *(const bf16x8*)(gw0 + ks * 512); wa[1][ks] = *(const bf16x8*)(gw1 + ks * 512); }
  __syncthreads();
#pragma unroll
  for (int p = 0; p < 4; ++p) *(u32x4*)(sB + so + 32 * 72 * p) = rb[p];
  __syncthreads();
  const int fo_b = (wn * 64 + (lane & 31)) * 72 + (lane >> 5) * 8;
  auto compute = [&](int cur, bf16x8 (&wf)[2][4]) {
    const u16* pb = sB + cur * 128 * 72 + fo_b;
#pragma unroll
    for (int ks = 0; ks < 4; ++ks) {
      const bf16x8 b0 = *(const bf16x8*)(pb + ks * 16), b1 = *(const bf16x8*)(pb + 32 * 72 + ks * 16);
      acc[0][0] = MFMA(wf[0][ks], b0, acc[0][0]); acc[0][1] = MFMA(wf[0][ks], b1, acc[0][1]);
      acc[1][0] = MFMA(wf[1][ks], b0, acc[1][0]); acc[1][1] = MFMA(wf[1][ks], b1, acc[1][1]);
    }
  };
  for (int kt = 0; kt < nk; kt += 2) {
    {
      const int k0 = (kt + 1) * 64;
#pragma unroll
      for (int p = 0; p < 4; ++p) rb[p] = *(const u32x4*)(gb + p * sb32 + k0);
#pragma unroll
      for (int ks = 0; ks < 4; ++ks) { wb[0][ks] = *(const bf16x8*)(gw0 + ((kt + 1) * 4 + ks) * 512); wb[1][ks] = *(const bf16x8*)(gw1 + ((kt + 1) * 4 + ks) * 512); }
    }
    compute(0, wa);
#pragma unroll
    for (int p = 0; p < 4; ++p) *(u32x4*)(sB + 128 * 72 + so + 32 * 72 * p) = rb[p];
    __syncthreads();
    {
      const int kn = (kt + 2 < nk) ? kt + 2 : nk - 1;
#pragma unroll
      for (int p = 0; p < 4; ++p) rb[p] = *(const u32x4*)(gb + p * sb32 + kn * 64);
#pragma unroll
      for (int ks = 0; ks < 4; ++ks) { wa[0][ks] = *(const bf16x8*)(gw0 + (kn * 4 + ks) * 512); wa[1][ks] = *(const bf16x8*)(gw1 + (kn * 4 + ks) * 512); }
    }
    compute(1, wb);
    if (kt + 2 < nk) {
#pragma unroll
      for (int p = 0; p < 4; ++p) *(u32x4*)(sB + so + 32 * 72 * p) = rb[p];
    }
    __syncthreads();
  }
}

DI void gemm_tile_wf4(const u16* Wfm, int K, int nrow0, const u16* Act, int ldact, f32x16 (&acc)[4], int Kp = 0, int ks0 = 0) {
  u16* sB = (u16*)smem;
  const int tid = TID(), lane = tid & 63, w = tid >> 6;
  const int lr = tid >> 3, lc = (tid & 7) * 8;
  const u16* gb = Act + (size_t)lr * ldact + lc;
  const size_t sb32 = (size_t)32 * ldact;
  const int kq = K >> 4;
  const u16* gw = Wfm + ((size_t)((nrow0 >> 5) + w) * kq + ks0) * 512 + lane * 8;
  const int so = lr * 72 + lc;
  const int nk = (Kp ? Kp : K) >> 6;
  u32x4 rb[4];
  bf16x8 wa[4], wb[4];
#pragma unroll
  for (int p = 0; p < 4; ++p) rb[p] = *(const u32x4*)(gb + p * sb32);
#pragma unroll
  for (int ks = 0; ks < 4; ++ks) wa[ks] = *(const bf16x8*)(gw + ks * 512);
  __syncthreads();
#pragma unroll
  for (int p = 0; p < 4; ++p) *(u32x4*)(sB + so + 32 * 72 * p) = rb[p];
  __syncthreads();
  const int fo_b = (lane & 31) * 72 + (lane >> 5) * 8;
  auto compute = [&](int cur, bf16x8 (&wf)[4]) {
    const u16* pb = sB + cur * 128 * 72 + fo_b;
#pragma unroll
    for (int ks = 0; ks < 4; ++ks) {
#pragma unroll
      for (int j = 0; j < 4; ++j) acc[j] = MFMA(wf[ks], *(const bf16x8*)(pb + j * 32 * 72 + ks * 16), acc[j]);
    }
  };
  for (int kt = 0; kt < nk; kt += 2) {
    {
      const int k0 = (kt + 1) * 64;
#pragma unroll
      for (int p = 0; p < 4; ++p) rb[p] = *(const u32x4*)(gb + p * sb32 + k0);
#pragma unroll
      for (int ks = 0; ks < 4; ++ks) wb[ks] = *(const bf16x8*)(gw + ((kt + 1) * 4 + ks) * 512);
    }
    compute(0, wa);
#pragma unroll
    for (int p = 0; p < 4; ++p) *(u32x4*)(sB + 128 * 72 + so + 32 * 72 * p) = rb[p];
    __syncthreads();
    {
      const int kn = (kt + 2 < nk) ? kt + 2 : nk - 1;
#pragma unroll
      for (int p = 0; p < 4; ++p) rb[p] = *(const u32x4*)(gb + p * sb32 + kn * 64);
#pragma unroll
      for (int ks = 0; ks < 4; ++ks) wa[ks] = *(const bf16x8*)(gw + (kn * 4 + ks) * 512);
    }
    compute(1, wb);
    if (kt + 2 < nk) {
#pragma unroll
      for (int p = 0; p < 4; ++p) *(u32x4*)(sB + so + 32 * 72 * p) = rb[p];
    }
    __syncthreads();
  }
}

DI void gemm_tile_wf8(const u16* Wfm, int K, int nrow0, const u16* Act, int ldact, f32x16 (&acc)[8]) {
  u16* sB = (u16*)smem;
  const int tid = TID(), lane = tid & 63, w = tid >> 6;
  const int lr = tid >> 3, lc = (tid & 7) * 8;
  const u16* gb = Act + (size_t)lr * ldact + lc;
  const size_t sb32 = (size_t)32 * ldact;
  const int kq = K >> 4;
  const u16* gw = Wfm + ((size_t)((nrow0 >> 5) + w) * kq) * 512 + lane * 8;
  const int so = lr * 72 + lc;
  const int nk = K >> 6;
  u32x4 rb[8];
  bf16x8 wa[4], wb[4];
#pragma unroll
  for (int p = 0; p < 8; ++p) rb[p] = *(const u32x4*)(gb + p * sb32);
#pragma unroll
  for (int ks = 0; ks < 4; ++ks) wa[ks] = *(const bf16x8*)(gw + ks * 512);
  __syncthreads();
#pragma unroll
  for (int p = 0; p < 8; ++p) *(u32x4*)(sB + so + 32 * 72 * p) = rb[p];
  __syncthreads();
  const int fo_b = (lane & 31) * 72 + (lane >> 5) * 8;
  auto compute = [&](int cur, bf16x8 (&wf)[4]) {
    const u16* pb = sB + cur * 256 * 72 + fo_b;
#pragma unroll
    for (int ks = 0; ks < 4; ++ks) {
#pragma unroll
      for (int j = 0; j < 8; ++j) acc[j] = MFMA(wf[ks], *(const bf16x8*)(pb + j * 32 * 72 + ks * 16), acc[j]);
    }
  };
  for (int kt = 0; kt < nk; kt += 2) {
    {
      const int k0 = (kt + 1) * 64;
#pragma unroll
      for (int p = 0; p < 8; ++p) rb[p] = *(const u32x4*)(gb + p * sb32 + k0);
#pragma unroll
      for (int ks = 0; ks < 4; ++ks) wb[ks] = *(const bf16x8*)(gw + ((kt + 1) * 4 + ks) * 512);
    }
    compute(0, wa);
#pragma unroll
    for (int p = 0; p < 8; ++p) *(u32x4*)(sB + 256 * 72 + so + 32 * 72 * p) = rb[p];
    __syncthreads();
    {
      const int kn = (kt + 2 < nk) ? kt + 2 : nk - 1;
#pragma unroll
      for (int p = 0; p < 8; ++p) rb[p] = *(const u32x4*)(gb + p * sb32 + kn * 64);
#pragma unroll
      for (int ks = 0; ks < 4; ++ks) wa[ks] = *(const bf16x8*)(gw + (kn * 4 + ks) * 512);
    }
    compute(1, wb);
    if (kt + 2 < nk) {
#pragma unroll
      for (int p = 0; p < 8; ++p) *(u32x4*)(sB + so + 32 * 72 * p) = rb[p];
    }
    __syncthreads();
  }
}

template <class F> DI void stage_bf16_w8(F f) {
  u16* sC = (u16*)smem;
  const int lane = TID() & 63, w = TID() >> 6, h = lane >> 5, c = lane & 31;
#pragma unroll
  for (int j = 0; j < 8; ++j)
#pragma unroll
    for (int g = 0; g < 4; ++g) {
      u32x2 pk; pk[0] = pk2(f(j, 4 * g), f(j, 4 * g + 1)); pk[1] = pk2(f(j, 4 * g + 2), f(j, 4 * g + 3));
      *(u32x2*)(sC + (j * 32 + c) * 136 + w * 32 + 8 * g + 4 * h) = pk;
    }
  __syncthreads();
}
DI void copy_out_bf16_256x128(u16* dst, size_t ld, int valid) {
  const u16* sC = (const u16*)smem;
  const int tid = TID();
#pragma unroll
  for (int q = 0; q < 16; ++q) {
    const int id = tid + 256 * q, row = id >> 4, cc = id & 15;
    if (cc * 8 < valid) *(u32x4*)(dst + (size_t)row * ld + cc * 8) = *(const u32x4*)(sC + row * 136 + cc * 8);
  }
}
template <class F> DI void stage_bf16_w8u(F f) {
  u16* sC = (u16*)smem;
  const int lane = TID() & 63, w = TID() >> 6, h = lane >> 5, c = lane & 31;
#pragma unroll
  for (int j = 0; j < 8; ++j)
#pragma unroll
    for (int g = 0; g < 2; ++g) {
      u32x2 pk; pk[0] = pk2(f(j, 4 * g), f(j, 4 * g + 1)); pk[1] = pk2(f(j, 4 * g + 2), f(j, 4 * g + 3));
      *(u32x2*)(sC + (j * 32 + c) * 72 + w * 16 + 8 * g + 4 * h) = pk;
    }
  __syncthreads();
}
DI void copy_out_bf16_256x64(u16* dst, size_t ld) {
  const u16* sC = (const u16*)smem;
  const int tid = TID();
#pragma unroll
  for (int q = 0; q < 8; ++q) {
    const int id = tid + 256 * q, row = id >> 3, cc = id & 7;
    *(u32x4*)(dst + (size_t)row * ld + cc * 8) = *(const u32x4*)(sC + row * 72 + cc * 8);
  }
}
template <class F> DI void stage_bf16_w4(F f) {
  u16* sC = (u16*)smem;
  const int lane = TID() & 63, w = TID() >> 6, h = lane >> 5, c = lane & 31;
#pragma unroll
  for (int j = 0; j < 4; ++j)
#pragma unroll
    for (int g = 0; g < 4; ++g) {
      u32x2 pk; pk[0] = pk2(f(j, 4 * g), f(j, 4 * g + 1)); pk[1] = pk2(f(j, 4 * g + 2), f(j, 4 * g + 3));
      *(u32x2*)(sC + (j * 32 + c) * 136 + w * 32 + 8 * g + 4 * h) = pk;
    }
  __syncthreads();
}

template <class F> DI void stage_bf16_w4u(F f) {
  u16* sC = (u16*)smem;
  const int lane = TID() & 63, w = TID() >> 6, h = lane >> 5, c = lane & 31;
#pragma unroll
  for (int j = 0; j < 4; ++j)
#pragma unroll
    for (int g = 0; g < 2; ++g) {
      u32x2 pk; pk[0] = pk2(f(j, 4 * g), f(j, 4 * g + 1)); pk[1] = pk2(f(j, 4 * g + 2), f(j, 4 * g + 3));
      *(u32x2*)(sC + (j * 32 + c) * 72 + w * 16 + 8 * g + 4 * h) = pk;
    }
  __syncthreads();
}
DI void stage_f32_w4(f32x16 (&acc)[4]) {
  float* sC = (float*)smem;
  const int lane = TID() & 63, w = TID() >> 6, h = lane >> 5, c = lane & 31;
#pragma unroll
  for (int j = 0; j < 4; ++j)
#pragma unroll
    for (int g = 0; g < 4; ++g) {
      f4 v; v[0] = acc[j][4 * g]; v[1] = acc[j][4 * g + 1]; v[2] = acc[j][4 * g + 2]; v[3] = acc[j][4 * g + 3];
      *(f4*)(sC + (j * 32 + c) * 132 + w * 32 + 8 * g + 4 * h) = v;
    }
  __syncthreads();
}
DI void zero_acc(f32x16 (&acc)[2][2]) {
#pragma unroll
  for (int i = 0; i < 2; ++i)
#pragma unroll
    for (int j = 0; j < 2; ++j)
#pragma unroll
      for (int r = 0; r < 16; ++r) acc[i][j][r] = 0.f;
}
template <class F> DI void epi(f32x16 (&acc)[2][2], F f) {
  const int lane = TID() & 63, w = TID() >> 6, wm = w >> 1, wn = w & 1, h = lane >> 5, c = lane & 31;
#pragma unroll
  for (int i = 0; i < 2; ++i)
#pragma unroll
    for (int j = 0; j < 2; ++j)
#pragma unroll
      for (int r = 0; r < 16; ++r) f(wm * 64 + i * 32 + crow(r, h), wn * 64 + j * 32 + c, acc[i][j][r]);
}

template <int W, class F> DI void stage_bf16(F f) {
  u16* sC = (u16*)smem;
  const int lane = TID() & 63, w = TID() >> 6, wm = w >> 1, wn = w & 1, h = lane >> 5, c = lane & 31;
#pragma unroll
  for (int i = 0; i < 2; ++i)
#pragma unroll
    for (int j = 0; j < (W == 128 ? 2 : 1); ++j)
#pragma unroll
      for (int r = 0; r < 16; ++r) sC[(wm * 64 + i * 32 + crow(r, h)) * (W + 8) + wn * (W / 2) + j * 32 + c] = f2bf(f(i, j, r));
  __syncthreads();
}
template <int W> DI void copy_out_bf16(u16* dst, size_t ld, int valid) {
  const u16* sC = (const u16*)smem;
  constexpr int CPR = W / 8;
  const int tid = TID();
#pragma unroll
  for (int q = 0; q < 128 * CPR / 256; ++q) {
    const int id = tid + 256 * q, row = id / CPR, cc = id % CPR;
    if (cc * 8 < valid) *(u32x4*)(dst + (size_t)row * ld + cc * 8) = *(const u32x4*)(sC + row * (W + 8) + cc * 8);
  }
}

template <class F> DI void stage_bf16_sw(F f) {
  u16* sC = (u16*)smem;
  const int lane = TID() & 63, w = TID() >> 6, wm = w >> 1, wn = w & 1, h = lane >> 5, c = lane & 31;
#pragma unroll
  for (int i = 0; i < 2; ++i)
#pragma unroll
    for (int j = 0; j < 2; ++j)
#pragma unroll
      for (int g = 0; g < 4; ++g) {
        u32x2 pk; pk[0] = pk2(f(i, j, 4 * g), f(i, j, 4 * g + 1)); pk[1] = pk2(f(i, j, 4 * g + 2), f(i, j, 4 * g + 3));
        *(u32x2*)(sC + (wn * 64 + j * 32 + c) * 136 + wm * 64 + i * 32 + 8 * g + 4 * h) = pk;
      }
  __syncthreads();
}
template <class F> DI void stage_bf16_sw64(F f) {
  u16* sC = (u16*)smem;
  const int lane = TID() & 63, w = TID() >> 6, wm = w >> 1, wn = w & 1, h = lane >> 5, c = lane & 31;
#pragma unroll
  for (int j = 0; j < 2; ++j)
#pragma unroll
    for (int g = 0; g < 4; ++g) {
      u32x2 pk; pk[0] = pk2(f(j, 4 * g), f(j, 4 * g + 1)); pk[1] = pk2(f(j, 4 * g + 2), f(j, 4 * g + 3));
      *(u32x2*)(sC + (wn * 64 + j * 32 + c) * 72 + wm * 32 + 8 * g + 4 * h) = pk;
    }
  __syncthreads();
}
DI void stage_f32(f32x16 (&acc)[2][2]) {
  float* sC = (float*)smem;
  const int lane = TID() & 63, w = TID() >> 6, wm = w >> 1, wn = w & 1, h = lane >> 5, c = lane & 31;
#pragma unroll
  for (int i = 0; i < 2; ++i)
#pragma unroll
    for (int j = 0; j < 2; ++j)
#pragma unroll
      for (int r = 0; r < 16; ++r) sC[(wm * 64 + i * 32 + crow(r, h)) * 132 + wn * 64 + j * 32 + c] = acc[i][j][r];
  __syncthreads();
}
DI int vblock() { const int nb = gridDim.x, b = BID(); return (nb & 7) ? b : (b & 7) * (nb >> 3) + (b >> 3); }
DI void decode_tile(int idx, int NT, int& mt, int& nt) { const int g = idx / (8 * NT); const int r = idx - g * 8 * NT; nt = r >> 3; mt = g * 8 + (r & 7); }


DI void group_sync(const Params& p, int& nbar) {
  if (!USE_GSYNC) return;
  __syncthreads();
  nbar += 1;
  if ((gridDim.x & 7) == 0 && TID() == 0) {
    u32* c = (u32*)(WSP(p) + WS_CTR) + 64 + 32 * (BID() & 7);
    const u32 target = (gridDim.x >> 3) * (u32)nbar;
    __hip_atomic_fetch_add(c, 1u, __ATOMIC_RELAXED, __HIP_MEMORY_SCOPE_AGENT);
    while (__hip_atomic_load(c, __ATOMIC_RELAXED, __HIP_MEMORY_SCOPE_AGENT) < target) __builtin_amdgcn_s_sleep(1);
  }
  __syncthreads();
}
#define TILE_LOOP(NT_TOTAL) \
  for (int rd_ = 0, idx = vblock(); rd_ < ((NT_TOTAL) + (int)gridDim.x - 1) / (int)gridDim.x; ++rd_, idx += gridDim.x)


#define XB_TMO      128
#define XB_XCNT(j)  (256  + 64 * (j))
#define XB_XSUB(j)  (1280 + 64 * (j))
#define XB_XGEN(j)  (2304 + 64 * (j))
#define XB_TOP      3328
#define XB_TOPGEN   3392
#define XCD_BAR_WORDS 3456
#define XB_SPIN_CAP (1u << 20)
#define LAS __attribute__((address_space(3)))
DI unsigned xb_ld(unsigned* p) { return __hip_atomic_load(p, __ATOMIC_RELAXED, __HIP_MEMORY_SCOPE_AGENT); }
DI unsigned xb_add(unsigned* p, unsigned v) { return __hip_atomic_fetch_add(p, v, __ATOMIC_RELAXED, __HIP_MEMORY_SCOPE_AGENT); }
DI unsigned xb_xcc_id() { return (unsigned)__builtin_amdgcn_s_getreg((3 << 11) | 20) & 0xFu; }
#define XB_SPIN(cond, bar) do { unsigned _sp = 0; while (cond) { __builtin_amdgcn_s_sleep(1); \
    if ((++_sp & 255u) == 0u) { if (xb_ld(&(bar)[XB_TMO])) break; if (_sp > XB_SPIN_CAP) { atomicAdd(&(bar)[XB_TMO], 1u); break; } } } } while (0)
__shared__ uint4 xb_words;
DI void xcd_barrier_complete(unsigned* bar, unsigned x, unsigned& nloc, unsigned& nx) {
  const unsigned G = gridDim.x;
  unsigned sum, cnt, mine, sp = 0u;
  for (;;) {
    sum = 0u; cnt = 0u; mine = 0u;
#pragma unroll
    for (unsigned j = 0; j < 16; ++j) { const unsigned c = xb_ld(&bar[XB_XCNT(j)]); sum += c; cnt += (c > 0u) ? 1u : 0u; mine = (j == x) ? c : mine; }
    if (sum == G) break;
    __builtin_amdgcn_s_sleep(1);
    if ((++sp & 255u) == 0u) { if (xb_ld(&bar[XB_TMO])) break; if (sp > XB_SPIN_CAP) { atomicAdd(&bar[XB_TMO], 1u); break; } }
  }
  nloc = mine > 0u ? mine : 1u; nx = cnt > 0u ? cnt : 1u;
}
DI void gsync(const Params& p) {
  asm volatile("s_waitcnt vmcnt(0)" ::: "memory");
  __syncthreads();
  if (threadIdx.x == 0) {
    unsigned* bar = (unsigned*)(WSP(p) + WS_BAR);
    volatile LAS unsigned* st = (volatile LAS unsigned*)&xb_words;
    const unsigned x = xb_xcc_id();
    __builtin_amdgcn_s_waitcnt(0);
    unsigned nloc = st[0], nx = st[1];
    if (nloc == 0u) { xcd_barrier_complete(bar, x, nloc, nx); st[0] = nloc; st[1] = nx; }
    const unsigned old = xb_add(&bar[XB_XSUB(x)], 1u);
    const unsigned gen = old / nloc;
    if (old + 1u == (gen + 1u) * nloc) {
      __builtin_amdgcn_fence(__ATOMIC_RELEASE, "agent");
      asm volatile("s_waitcnt vmcnt(0)" ::: "memory");
      const unsigned og = xb_add(&bar[XB_TOP], 1u);
      const unsigned tg = og / nx;
      if (og + 1u == (tg + 1u) * nx) xb_add(&bar[XB_TOPGEN], 1u);
      else XB_SPIN(xb_ld(&bar[XB_TOPGEN]) == tg, bar);
      __builtin_amdgcn_fence(__ATOMIC_ACQUIRE, "agent");
      xb_add(&bar[XB_XGEN(x)], 1u);
      asm volatile("s_waitcnt vmcnt(0)" ::: "memory");
    } else {
      XB_SPIN(xb_ld(&bar[XB_XGEN(x)]) == gen, bar);
      __builtin_amdgcn_fence(__ATOMIC_ACQUIRE, "agent");
      asm volatile("s_waitcnt vmcnt(0)" ::: "memory");
    }
  }
  __syncthreads();
}

DI void conv_matrix(const float* src, int K, int ldn, int N, u16* dst, const float* scale, int mode, int off, int rot) {
  float* sm = (float*)smem;
  const int tid = TID(), nb = gridDim.x;
  const int nkt = K >> 6, nnt = (N + 63) >> 6;
  int b0 = BID() - rot; if (b0 < 0) b0 += nb;
  for (int it = b0; it < nkt * nnt; it += nb) {
    const int kt = it % nkt, nt = it / nkt, k0 = kt * 64, n0 = nt * 64;
    __syncthreads();
    const int r = tid >> 4, c4 = (tid & 15) * 4;
#pragma unroll
    for (int p = 0; p < 4; ++p) {
      const int k = r + 16 * p;
      f4 v = {0.f, 0.f, 0.f, 0.f};
      if (n0 + c4 < N) v = *(const f4*)(src + (size_t)(k0 + k) * ldn + n0 + c4);
      if (scale) { const float s = scale[k0 + k]; v *= s; }
      sm[k * 65 + c4 + 0] = v[0]; sm[k * 65 + c4 + 1] = v[1]; sm[k * 65 + c4 + 2] = v[2]; sm[k * 65 + c4 + 3] = v[3];
    }
    __syncthreads();
    const int n = tid & 63, kc = tid >> 6;
    if (n0 + n < N) {
      const int ng = n0 + n;
      const int row = (mode & 4) ? ((ng >> 4) * 32 + (ng & 15) + off) : (mode & 1) ? ((ng >> 5) * 64 + (ng & 31) + off) : ng;
#pragma unroll
      for (int q = 0; q < 2; ++q) {
        const int c = kc + 4 * q;
        const float* s = sm + (8 * c) * 65 + n;
        u32x4 o;
        o[0] = pk2(s[0], s[65]); o[1] = pk2(s[2 * 65], s[3 * 65]); o[2] = pk2(s[4 * 65], s[5 * 65]); o[3] = pk2(s[6 * 65], s[7 * 65]);
        if (mode & 2) *(u32x4*)(dst + ((size_t)(row >> 5) * (K >> 4) + ((k0 + 8 * c) >> 4)) * 512 + (((k0 + 8 * c) >> 3) & 1) * 256 + (row & 31) * 8) = o;
        else *(u32x4*)(dst + (size_t)row * K + k0 + 8 * c) = o;
      }
    }
  }
}

DI void norm_phase(const Params& p, int l, int which) {
  const float* X = OUTP(p);
  u16* H = (u16*)(WSP(p) + WS_H);
  const float* nw = INP(p, which ? I_N2 : I_N1) + l * 1024;
  const float* MOD = (const float*)(WSP(p) + WS_MOD) + (size_t)l * 5 * 6144;
  const int lane = TID() & 63, gw = BID() * 4 + (TID() >> 6), nw_ = gridDim.x * 4;
  for (int t = gw; t < T; t += nw_) {
    const int cb = t < TC ? 0 : 1 + ((t - TC) >> 12);
    const float* sh = MOD + cb * 6144 + (which ? 3 : 0) * 1024;
    const float* sc = sh + 1024;
    const f4* xr = (const f4*)(X + (size_t)t * 1024) + lane;
    f4 v[4]; float s = 0.f;
#pragma unroll
    for (int j = 0; j < 4; ++j) { v[j] = xr[64 * j]; s += v[j][0] * v[j][0] + v[j][1] * v[j][1] + v[j][2] * v[j][2] + v[j][3] * v[j][3]; }
    const float rstd = rsqrtf(wave_sum(s) * (1.f / 1024.f) + EPS);
#pragma unroll
    for (int j = 0; j < 4; ++j) {
      const int c = 4 * lane + 256 * j;
      const f4 wv = *(const f4*)(nw + c), scv = *(const f4*)(sc + c), shv = *(const f4*)(sh + c);
      float o[4];
#pragma unroll
      for (int e = 0; e < 4; ++e) o[e] = v[j][e] * rstd * wv[e] * (1.f + scv[e]) + shv[e];
      u32x2 pk; pk[0] = pk2(o[0], o[1]); pk[1] = pk2(o[2], o[3]);
      *(u32x2*)(H + (size_t)t * 1024 + c) = pk;
    }
  }
}

DI void pre_phase(const Params& p) {
  const int tid = TID(), nb = gridDim.x;
  if (BID() == 0) { for (int i = tid; i < 1024; i += 256) ((u32*)(WSP(p) + WS_CTR))[i] = 0u; }
  {
    f4* X4 = (f4*)OUTP(p);
    const f4* xp = (const f4*)INP(p, I_XP); const f4* xs = (const f4*)INP(p, I_XS);
    const int n4 = T * 256, nc4 = TC * 256;
    for (int i = BID() * 256 + tid; i < n4; i += nb * 256) X4[i] = (i < nc4) ? xp[i] : xs[i - nc4];
  }
  float* sm = (float*)smem;
  float* MOD = (float*)(WSP(p) + WS_MOD);
  __syncthreads();
  for (int i = tid; i < 5 * 1024; i += 256) {
    const int cb = i >> 10, k = i & 1023;
    const float cv = cb == 0 ? INP(p, I_CCTX)[k] : INP(p, I_C)[(cb - 1) * 1024 + k];
    sm[i] = silu_f(cv);
  }
  __syncthreads();
  float* red = sm + 5 * 1024;
  for (int it = BID(); it < NLAYER * 48; it += nb) {
    const int l = it / 48, n0 = (it % 48) * 128;
    const int c4 = (tid & 31) * 4, kg = tid >> 5;
    float a[5][4];
#pragma unroll
    for (int cb = 0; cb < 5; ++cb)
#pragma unroll
      for (int e = 0; e < 4; ++e) a[cb][e] = 0.f;
    const float* wsrc = INP(p, I_WADA) + (size_t)l * 1024 * 6144 + n0 + c4;
    for (int k = kg * 128; k < kg * 128 + 128; ++k) {
      const f4 wv = *(const f4*)(wsrc + (size_t)k * 6144);
#pragma unroll
      for (int cb = 0; cb < 5; ++cb) {
        const float s = sm[cb * 1024 + k];
#pragma unroll
        for (int e = 0; e < 4; ++e) a[cb][e] += s * wv[e];
      }
    }
    __syncthreads();
#pragma unroll
    for (int cb = 0; cb < 5; ++cb)
#pragma unroll
      for (int e = 0; e < 4; ++e) red[(kg * 5 + cb) * 128 + c4 + e] = a[cb][e];
    __syncthreads();
    for (int o = tid; o < 5 * 128; o += 256) {
      const int cb = o >> 7, n = o & 127;
      float s = INP(p, I_BADA)[l * 6144 + n0 + n];
#pragma unroll
      for (int g = 0; g < 8; ++g) s += red[(g * 5 + cb) * 128 + n];
      MOD[((size_t)l * 5 + cb) * 6144 + n0 + n] = s;
    }
  }
}

DI void l1_phase(const Params& p, int l) {
  u16* W = (u16*)(WSP(p) + WS_W);
  conv_matrix(INP(p, I_WIN) + (size_t)l * 1024 * INC, 1024, INC, NPROJ, W + W_IN, nullptr, 2, 0, 0);
  conv_matrix(INP(p, I_WIN) + (size_t)l * 1024 * INC + NPROJ, 1024, INC, 3072, W + W_GATE, nullptr, 2, 0, 300);
  conv_matrix(INP(p, I_F1) + (size_t)l * 1024 * FF, 1024, FF, FF, W + W_F13, nullptr, 6, 0, 64);
  conv_matrix(INP(p, I_F3) + (size_t)l * 1024 * FF, 1024, FF, FF, W + W_F13, nullptr, 6, 16, 128);
  conv_matrix(INP(p, I_F2) + (size_t)l * FF * 1024, FF, 1024, 1024, W + W_F2, nullptr, 2, 0, 192);
  conv_matrix(INP(p, I_WAO) + (size_t)l * 512 * 1024, 512, 1024, 1024, W + W_A, nullptr, 0, 0, 32);
  conv_matrix(INP(p, I_WBO) + (size_t)l * 1024 * 1024, 1024, 1024, 1024, W + W_B, INP(p, I_SNW) + l * 1024, 0, 0, 96);
  conv_matrix(INP(p, I_WUQ) + (size_t)l * 256 * 768, 256, 768, 768, W + W_UQ, INP(p, I_QNW) + l * 256, 0, 0, 160);
  conv_matrix(INP(p, I_WUKV) + (size_t)l * 256 * 1024, 256, 1024, 1024, W + W_UKV, nullptr, 0, 0, 224);
  conv_matrix(INP(p, I_WCO) + (size_t)l * 512 * 1024, 512, 1024, 1024, W + W_C, nullptr, 0, 0, 16);
  conv_matrix(INP(p, I_WO) + (size_t)l * 1024 * 1024, 1024, 1024, 1024, W + W_O, nullptr, 2, 0, 80);
  norm_phase(p, l, 0);
}

DI void l2_phase(const Params& p, int l, int& nbar) {
  const u16* H = (const u16*)(WSP(p) + WS_H);
  const u16* W = (const u16*)(WSP(p) + WS_W) + W_IN;
  u16* ACT = (u16*)(WSP(p) + WS_ACT);
  float* DT = (float*)(WSP(p) + WS_DT);
  constexpr int NT = 37, MT = 80;
  TILE_LOOP(MT * NT) {
    group_sync(p, nbar);
    if (idx >= MT * NT) continue;
    int mt, nt; decode_tile(idx, NT, mt, nt);
    f32x16 acc[8];
#pragma unroll
    for (int j = 0; j < 8; ++j)
#pragma unroll
      for (int r = 0; r < 16; ++r) acc[j][r] = 0.f;
    gemm_tile_wf8(W, 1024, nt * 128, H + (size_t)mt * 256 * 1024, 1024, acc);
    const int m0 = mt * 256, n0 = nt * 128;
    if (nt == 32 || (nt == 36 && mt < 16)) {
      const int lane = TID() & 63, w = TID() >> 6, h = lane >> 5, c = lane & 31;
#pragma unroll
      for (int j = 0; j < 8; ++j)
#pragma unroll
        for (int r = 0; r < 16; ++r) {
          const int t = m0 + j * 32 + c, cc = n0 + w * 32 + crow(r, h);
          const float v = acc[j][r];
          if (cc >= C_DT && cc < C_DT + 16) DT[t * 16 + cc - C_DT] = v;
          if (cc >= C_KR && cc < NPROJ && t < TC) OUTP(p)[O_KR + ((size_t)((t >> 8) * 4 + l) * 256 + (t & 255)) * 32 + (cc - C_KR)] = v;
        }
    }
    stage_bf16_w8([&](int j, int r) { return acc[j][r]; });
    copy_out_bf16_256x128(ACT + (size_t)m0 * LDA + n0, LDA, NPROJ - n0);
  }
}

DI void unpack8(const u32x4 v, float (&f)[8]) {
#pragma unroll
  for (int i = 0; i < 4; ++i) { f[2 * i] = bflo(v[i]); f[2 * i + 1] = bfhi(v[i]); }
}
DI u32x4 pack8(const float (&f)[8]) { u32x4 o; o[0] = pk2(f[0], f[1]); o[1] = pk2(f[2], f[3]); o[2] = pk2(f[4], f[5]); o[3] = pk2(f[6], f[7]); return o; }

DI void l3_phase(const Params& p, int l) {
  const u16* ACT = (const u16*)(WSP(p) + WS_ACT);
  const int tid = TID(), nb = gridDim.x;
  {
    u16* YA = (u16*)(WSP(p) + WS_YA);
    const float* cw = INP(p, I_ACW) + l * 3 * 512;
    for (int it = BID() * 256 + tid; it < T * 64; it += nb * 256) {
      const int t = it >> 6, c8 = (it & 63) * 8;
      const int pos = t < TC ? (t & 255) : ((t - TC) & 4095);
      const int L = t < TC ? 256 : 4096;
      const u16* row = ACT + (size_t)t * LDA;
      float u0[8], u1[8], u2[8], ab[8], a1[8], a2[8];
      unpack8(*(const u32x4*)(row + C_AX + c8), a1); unpack8(*(const u32x4*)(row + C_AC + c8), a2);
#pragma unroll
      for (int e = 0; e < 8; ++e) u1[e] = a1[e] * a2[e];
      if (pos > 0) {
        unpack8(*(const u32x4*)(row - LDA + C_AX + c8), a1); unpack8(*(const u32x4*)(row - LDA + C_AC + c8), a2);
#pragma unroll
        for (int e = 0; e < 8; ++e) u0[e] = a1[e] * a2[e];
      } else {
#pragma unroll
        for (int e = 0; e < 8; ++e) u0[e] = 0.f;
      }
      if (pos < L - 1) {
        unpack8(*(const u32x4*)(row + LDA + C_AX + c8), a1); unpack8(*(const u32x4*)(row + LDA + C_AC + c8), a2);
#pragma unroll
        for (int e = 0; e < 8; ++e) u2[e] = a1[e] * a2[e];
      } else {
#pragma unroll
        for (int e = 0; e < 8; ++e) u2[e] = 0.f;
      }
      unpack8(*(const u32x4*)(row + C_AB + c8), ab);
      float o[8];
#pragma unroll
      for (int e = 0; e < 8; ++e) o[e] = ab[e] * (cw[c8 + e] * u0[e] + cw[512 + c8 + e] * u1[e] + cw[1024 + c8 + e] * u2[e]);
      *(u32x4*)(YA + (size_t)t * 512 + c8) = pack8(o);
    }
  }
  {
    u16* XT = (u16*)(WSP(p) + WS_XT); u16* BCP = (u16*)(WSP(p) + WS_BCP); u16* BT = (u16*)(WSP(p) + WS_BT);
    const float* cw = INP(p, I_SCW) + l * 3 * 1536;
    const float* cbias = INP(p, I_SCB) + l * 1536;
    u16* sr = (u16*)smem;
    for (int it = BID(); it < 160 * 24; it += nb) {
      const int chunk = it / 24, cbk = it % 24, ch0 = cbk * 64, t0 = chunk * 128;
      const bool first = chunk < 32 ? ((chunk & 1) == 0) : (((chunk - 32) & 31) == 0);
      const bool last = chunk < 32 ? ((chunk & 1) == 1) : (((chunk - 32) & 31) == 31);
      __syncthreads();
      for (int id = tid; id < 130 * 8; id += 256) {
        const int r = id >> 3, c8 = (id & 7) * 8;
        u32x4 v = {0u, 0u, 0u, 0u};
        const bool ok = !((r == 0 && first) || (r == 129 && last));
        if (ok) v = *(const u32x4*)(ACT + (size_t)(t0 - 1 + r) * LDA + C_XBC + ch0 + c8);
        *(u32x4*)(sr + r * 72 + c8) = v;
      }
      __syncthreads();
      if (cbk >= 16) {
        const int c8 = (tid & 7) * 8;
        float w0[8], w1[8], w2[8], bb[8];
#pragma unroll
        for (int e = 0; e < 8; ++e) { w0[e] = cw[ch0 + c8 + e]; w1[e] = cw[1536 + ch0 + c8 + e]; w2[e] = cw[3072 + ch0 + c8 + e]; bb[e] = cbias[ch0 + c8 + e]; }
#pragma unroll
        for (int q = 0; q < 4; ++q) {
          const int r = (tid >> 3) + 32 * q;
          float x0[8], x1[8], x2[8], o[8];
          unpack8(*(const u32x4*)(sr + r * 72 + c8), x0); unpack8(*(const u32x4*)(sr + (r + 1) * 72 + c8), x1); unpack8(*(const u32x4*)(sr + (r + 2) * 72 + c8), x2);
#pragma unroll
          for (int e = 0; e < 8; ++e) o[e] = silu_f(w0[e] * x0[e] + w1[e] * x1[e] + w2[e] * x2[e] + bb[e]);
          *(u32x4*)(BCP + (size_t)(t0 + r) * 512 + (ch0 - 1024) + c8) = pack8(o);
        }
      }
      if (cbk < 20) {
        const int ch = tid & 63, jg0 = tid >> 6;
        const float w0 = cw[ch0 + ch], w1 = cw[1536 + ch0 + ch], w2 = cw[3072 + ch0 + ch], bb = cbias[ch0 + ch];
        u16* dst = cbk < 16 ? XT + ((size_t)chunk * 1024 + ch0 + ch) * 128 : BT + ((size_t)chunk * 256 + (ch0 - 1024) + ch) * 128;
#pragma unroll
        for (int q = 0; q < 4; ++q) {
          const int g = jg0 + 4 * q;
          float xv[10], o[8];
#pragma unroll
          for (int e = 0; e < 10; ++e) xv[e] = bf2f(sr[(8 * g + e) * 72 + ch]);
#pragma unroll
          for (int e = 0; e < 8; ++e) o[e] = silu_f(w0 * xv[e] + w1 * xv[e + 1] + w2 * xv[e + 2] + bb);
          *(u32x4*)(dst + 8 * g) = pack8(o);
        }
      }
    }
  }
  {
    u16* CKVA = (u16*)(WSP(p) + WS_CKVA); u16* KRA = (u16*)(WSP(p) + WS_KR);
    float* RQ = (float*)(WSP(p) + WS_RQ);
    const float* kvw = INP(p, I_KVNW) + l * 256;
    const int lane = tid & 63, gw = BID() * 4 + (tid >> 6), nwv = nb * 4;
    for (int it = gw; it < T + 2048; it += nwv) {
      if (it < T) {
        const int t = it;
        const u16* row = ACT + (size_t)t * LDA;
        const u32x2 kv = *(const u32x2*)(row + C_CKV + 4 * lane);
        const u32x2 qv = *(const u32x2*)(row + C_CQ + 4 * lane);
        float k4[4] = {bflo(kv[0]), bfhi(kv[0]), bflo(kv[1]), bfhi(kv[1])};
        float q4[4] = {bflo(qv[0]), bfhi(qv[0]), bflo(qv[1]), bfhi(qv[1])};
        const float ssk = wave_sum(k4[0] * k4[0] + k4[1] * k4[1] + k4[2] * k4[2] + k4[3] * k4[3]);
        const float ssq = wave_sum(q4[0] * q4[0] + q4[1] * q4[1] + q4[2] * q4[2] + q4[3] * q4[3]);
        const float rk = rsqrtf(ssk * (1.f / 256.f) + EPS);
        if (lane == 0) RQ[t] = rsqrtf(ssq * (1.f / 256.f) + EPS);
        const f4 wv = *(const f4*)(kvw + 4 * lane);
        f4 o; o[0] = k4[0] * rk * wv[0]; o[1] = k4[1] * rk * wv[1]; o[2] = k4[2] * rk * wv[2]; o[3] = k4[3] * rk * wv[3];
        int krow, pos;
        if (t < TC) { krow = KROW_CTX + t; pos = t & 255; *(f4*)(OUTP(p) + O_CKV + ((size_t)((t >> 8) * 4 + l) * 256 + pos) * 256 + 4 * lane) = o; }
        else { const int b = (t - TC) >> 12; pos = (t - TC) & 4095; krow = b * LKL + 512 + pos; }
        u32x2 pk; pk[0] = pk2(o[0], o[1]); pk[1] = pk2(o[2], o[3]);
        *(u32x2*)(CKVA + (size_t)krow * 256 + 4 * lane) = pk;
        if (lane < 16) {
          float x1 = bf2f(row[C_KR + lane]), x2 = bf2f(row[C_KR + 16 + lane]);
          if (t >= TC) {
            const float pp = (lane < 8) ? (float)(pos >> 6) : (float)(pos & 63);
            const float inv = exp2f(-(float)(lane & 7) * (13.287712379549449f / 8.f));
            const float ang = pp * inv;
            const float cs = cosf(ang), sn = sinf(ang);
            const float y1 = x1 * cs - x2 * sn, y2 = x1 * sn + x2 * cs;
            x1 = y1; x2 = y2;
          }
          KRA[(size_t)krow * 32 + lane] = f2bf(x1); KRA[(size_t)krow * 32 + 16 + lane] = f2bf(x2);
        }
      } else {
        const int j = it - T, b = j >> 9, r = j & 511;
        const int krow = b * LKL + r;
        const f4 v = *(const f4*)(INP(p, I_CCKV) + ((size_t)(b * 4 + l) * 512 + r) * 256 + 4 * lane);
        u32x2 pk; pk[0] = pk2(v[0], v[1]); pk[1] = pk2(v[2], v[3]);
        *(u32x2*)(CKVA + (size_t)krow * 256 + 4 * lane) = pk;
        if (lane < 32) KRA[(size_t)krow * 32 + lane] = f2bf(INP(p, I_CKR)[((size_t)(b * 4 + l) * 512 + r) * 32 + lane]);
      }
    }
  }
}

DI void l3d_phase(const Params& p, int l) {
  const float* DT = (const float*)(WSP(p) + WS_DT);
  float* CUMS = (float*)(WSP(p) + WS_CUMS);
  const int tid = TID(), lane = tid & 63, gw = BID() * 4 + (tid >> 6), nwv = gridDim.x * 4;
  for (int it = gw; it < 160 * 32; it += nwv) {
    const int chunk = it >> 5, dir = (it >> 4) & 1, head = it & 15, t0 = chunk * 128;
    const float a = -__expf(INP(p, I_ALOG)[(l * 2 + dir) * 16 + head]);
    const float dtb = INP(p, I_DTB)[(l * 2 + dir) * 16 + head];
    const int k0 = 2 * lane, k1 = 2 * lane + 1;
    const int tk0 = dir ? 127 - k0 : k0, tk1 = dir ? 127 - k1 : k1;
    const float x0 = DT[(t0 + tk0) * 16 + head] + dtb, x1 = DT[(t0 + tk1) * 16 + head] + dtb;
    const float d0 = x0 > 20.f ? x0 : log1pf(__expf(x0)), d1 = x1 > 20.f ? x1 : log1pf(__expf(x1));
    const float v0 = d0 * a, v1 = d1 * a;
    float s = v0 + v1;
#pragma unroll
    for (int o = 1; o < 64; o <<= 1) { const float n = __shfl_up(s, o); if (lane >= o) s += n; }
    const float total = __shfl(s, 63);
    const float c1 = s, c0 = s - v1;
    float* cs = CUMS + (size_t)it * 768;
    const float cref = __shfl(c1, (lane & ~7) | 7);
    cs[tk0] = c0; cs[tk1] = c1; cs[128 + tk0] = __expf(cref - c0) * d0; cs[128 + tk1] = __expf(cref - c1) * d1;
    cs[640 + tk0] = d0; cs[640 + tk1] = d1;
    {
      const float cfirst = __shfl(c0, lane & ~7);
      if ((lane & 7) == 7) { cs[520 + (tk1 >> 4)] = c1; cs[528 + (tk1 >> 4)] = cfirst - c1; }
    }
    cs[256 + tk0] = __expf(total - c0) * d0; cs[256 + tk1] = __expf(total - c1) * d1;
    cs[384 + tk0] = __expf(c0); cs[384 + tk1] = __expf(c1);
    if (lane == 0) cs[512] = __expf(total);
  }
}

DI void l4_phase(const Params& p, int l, int& nbar) {
  constexpr int NQ = 160 * 6, NKV = 176 * 8, NCB = 320;
  TILE_LOOP(NQ + NKV + NCB) {
    group_sync(p, nbar);
    if (idx >= NQ + NKV + NCB) continue;
    const u16* W = (const u16*)(WSP(p) + WS_W);
    const u16* ACT = (const u16*)(WSP(p) + WS_ACT);
    f32x16 acc[2][2]; zero_acc(acc);
    if (idx < NQ) {
      int mt, nt; decode_tile(idx, 6, mt, nt);
      gemm_tile(W + W_UQ + (size_t)nt * 128 * 256, 256, ACT + (size_t)mt * 128 * LDA + C_CQ, LDA, 256, acc);
      const float* RQ = (const float*)(WSP(p) + WS_RQ);
      u16* Q = (u16*)(WSP(p) + WS_Q);
      const int m0 = mt * 128, n0 = nt * 128;
      {
        const int lane = TID() & 63, w = TID() >> 6, wn = w & 1, c = lane & 31;
        const float rq0 = RQ[m0 + wn * 64 + c], rq1 = RQ[m0 + wn * 64 + 32 + c];
        stage_bf16_sw([&](int i, int j, int r) { return acc[i][j][r] * (j ? rq1 : rq0); });
        copy_out_bf16<128>(Q + (size_t)m0 * 768 + n0, 768, 128);
      }
    } else if (idx < NQ + NKV) {
      int mt, nt; decode_tile(idx - NQ, 8, mt, nt);
      gemm_tile((const u16*)(WSP(p) + WS_CKVA) + (size_t)mt * 128 * 256, 256, W + W_UKV + (size_t)nt * 128 * 256, 256, 256, acc);
      u16* KN = (u16*)(WSP(p) + WS_KN); u16* VT = (u16*)(WSP(p) + WS_VT);
      const int lane = TID() & 63, w = TID() >> 6, wm = w >> 1, wn = w & 1, h = lane >> 5, c = lane & 31;
      const int kr0 = mt * 128;
      size_t vbase; int Lk, key0;
      if (kr0 < KROW_CTX) { const int b = kr0 / LKL; key0 = kr0 - b * LKL; Lk = LKL; vbase = (size_t)b * 512 * LKL; }
      else { const int s = (kr0 - KROW_CTX) >> 8; key0 = (kr0 - KROW_CTX) & 255; Lk = 256; vbase = (size_t)4 * 512 * LKL + (size_t)s * 512 * 256; }
#pragma unroll
      for (int i = 0; i < 2; ++i)
#pragma unroll
        for (int j = 0; j < 2; ++j) {
          const int d = j * 32 + c;
          if (wn == 0) {
#pragma unroll
            for (int r = 0; r < 16; ++r) KN[(size_t)(kr0 + wm * 64 + i * 32 + crow(r, h)) * 512 + nt * 64 + d] = f2bf(acc[i][j][r]);
          } else {
#pragma unroll
            for (int g = 0; g < 4; ++g) {
              const int key = key0 + wm * 64 + i * 32 + 8 * g + 4 * h;
              u32x2 pk; pk[0] = pk2(acc[i][j][4 * g], acc[i][j][4 * g + 1]); pk[1] = pk2(acc[i][j][4 * g + 2], acc[i][j][4 * g + 3]);
              *(u32x2*)(VT + vbase + (size_t)(nt * 64 + d) * Lk + key) = pk;
            }
          }
        }
    } else {
      const int ci = idx - NQ - NKV, chunk = ci >> 1, g = ci & 1;
      const u16* BCP = (const u16*)(WSP(p) + WS_BCP) + (size_t)chunk * 128 * 512;
      gemm_tile(BCP + 256 + g * 128, 512, BCP + g * 128, 512, 128, acc);
      u16* CB = (u16*)(WSP(p) + WS_CB) + (size_t)ci * 128 * 128;
      epi(acc, [&](int m, int n, float v) { CB[m * 128 + n] = f2bf(v); });
    }
  }
}

DI void ssd_unit(const Params& p, int l, int unit) {
  const int tid = TID(), lane = tid & 63, w = __builtin_amdgcn_readfirstlane(tid >> 6), h = lane >> 5, c = lane & 31;
  int dir, head, nc, chunk0, sidx; bool lat;
  if (unit < 128) { lat = true; sidx = unit >> 5; dir = (unit >> 4) & 1; head = unit & 15; nc = 32; chunk0 = 32 + sidx * 32; }
  else { const int u = unit - 128; lat = false; sidx = u >> 5; dir = (u >> 4) & 1; head = u & 15; nc = 2; chunk0 = sidx * 2; }
  const int g = head >> 3;
  const float Dk = INP(p, I_SD)[(l * 2 + dir) * 16 + head];
  u16* sXT = (u16*)smem; u16* sXS = sXT + 64 * 136; u16* sHS = sXS + 64 * 136;
  float* cum = (float*)(sHS + 64 * 136); float* dtv = cum + 128; float* ecum = dtv + 128; float* dtr = ecum + 128;
  const u16* XT = (const u16*)(WSP(p) + WS_XT); const u16* BCP = (const u16*)(WSP(p) + WS_BCP); const u16* BT = (const u16*)(WSP(p) + WS_BT);
  const u16* CB = (const u16*)(WSP(p) + WS_CB); const float* CUMS = (const float*)(WSP(p) + WS_CUMS);
  u16* Y = (u16*)(WSP(p) + WS_ACT) + (dir ? C_YB : C_YF);
  f32x16 S[2];
  if (lat) {
    const float* st = INP(p, dir ? I_STB : I_STF) + ((size_t)((sidx * 4 + l) * 16 + head) * 64) * 128;
#pragma unroll
    for (int mt = 0; mt < 2; ++mt)
#pragma unroll
      for (int r = 0; r < 16; ++r) S[mt][r] = st[(size_t)(32 * mt + crow(r, h)) * 128 + 32 * w + c];
  } else {
#pragma unroll
    for (int mt = 0; mt < 2; ++mt)
#pragma unroll
      for (int r = 0; r < 16; ++r) S[mt][r] = 0.f;
  }
  __syncthreads();
#pragma unroll
  for (int mt = 0; mt < 2; ++mt)
#pragma unroll
    for (int r = 0; r < 16; ++r) sHS[(32 * mt + crow(r, h)) * 136 + 32 * w + c] = f2bf(S[mt][r]);
  const int i = 32 * w + c;
  const int ks_lo = dir ? 2 * w : 0, ks_hi = dir ? 8 : 2 * w + 2;
  const int pr0 = tid >> 4, j0 = (tid & 15) * 8;

  for (int step = 0; step < nc; ++step) {
    const int chunk = chunk0 + (dir ? nc - 1 - step : step);
    const int t0 = chunk * 128;
    const float* cs = CUMS + ((size_t)(chunk * 2 + dir) * 16 + head) * 768;
    u32x4 xr[4];
    const u16* xsrc = XT + ((size_t)chunk * 1024 + head * 64) * 128;
#pragma unroll
    for (int q = 0; q < 4; ++q) xr[q] = *(const u32x4*)(xsrc + (size_t)(pr0 + 16 * q) * 128 + j0);
    const f4 e1lo = *(const f4*)(cs + 256 + j0), e1hi = *(const f4*)(cs + 256 + j0 + 4);
    float t_cum = 0.f, t_dt = 0.f, t_ec = 0.f;
    float t_dr = 0.f;
    if (tid < 128) { t_cum = cs[tid]; t_dt = cs[128 + tid]; t_ec = cs[384 + tid]; t_dr = cs[640 + tid]; }
    const float dec = cs[512];
    float cref8[8], span8[8];
#pragma unroll
    for (int ks = 0; ks < 8; ++ks) { cref8[ks] = cs[520 + ks]; span8[ks] = cs[528 + ks]; }
    const u16* crowp = BCP + (size_t)(t0 + i) * 512 + 256 + g * 128 + 8 * h;
    const u16* cbrow = CB + ((size_t)(chunk * 2 + g) * 128 + i) * 128 + 8 * h;
    const u16* btrow = BT + ((size_t)chunk * 256 + g * 128 + 32 * w + c) * 128 + 8 * h;
    bf16x8 cf[8], btf[8]; u32x4 cbf[8];
#pragma unroll
    for (int ks = 0; ks < 8; ++ks) cf[ks] = *(const bf16x8*)(crowp + ks * 16);
#pragma unroll
    for (int ks = 0; ks < 8; ++ks) { u32x4 z = {0u, 0u, 0u, 0u}; cbf[ks] = (ks >= ks_lo && ks < ks_hi) ? *(const u32x4*)(cbrow + ks * 16) : z; }
#pragma unroll
    for (int ks = 0; ks < 8; ++ks) btf[ks] = *(const bf16x8*)(btrow + ks * 16);
    __builtin_amdgcn_sched_barrier(0);
    if (tid < 128) { cum[tid] = t_cum; dtv[tid] = t_dt; ecum[tid] = t_ec; dtr[tid] = t_dr; }
    {
      const float e1v[8] = {e1lo[0], e1lo[1], e1lo[2], e1lo[3], e1hi[0], e1hi[1], e1hi[2], e1hi[3]};
#pragma unroll
      for (int q = 0; q < 4; ++q) {
        const int pr = pr0 + 16 * q;
        *(u32x4*)(sXT + pr * 136 + j0) = xr[q];
        float f[8]; unpack8(xr[q], f);
#pragma unroll
        for (int e = 0; e < 8; ++e) f[e] *= e1v[e];
        *(u32x4*)(sXS + pr * 136 + j0) = pack8(f);
      }
    }
    __syncthreads();
    f32x16 Y1[2];
#pragma unroll
    for (int nt = 0; nt < 2; ++nt)
#pragma unroll
      for (int r = 0; r < 16; ++r) Y1[nt][r] = 0.f;
#pragma unroll
    for (int ks = 0; ks < 8; ++ks) {
#pragma unroll
      for (int nt = 0; nt < 2; ++nt) {
        const bf16x8 bfv = *(const bf16x8*)(sHS + (32 * nt + c) * 136 + ks * 16 + 8 * h);
        Y1[nt] = MFMA(cf[ks], bfv, Y1[nt]);
      }
    }
#pragma unroll
    for (int nt = 0; nt < 2; ++nt)
#pragma unroll
      for (int r = 0; r < 16; ++r) Y1[nt][r] *= ecum[32 * w + crow(r, h)];
    const float ci_ = cum[i];
#pragma unroll
    for (int ks = 0; ks < 8; ++ks) {
      if (ks >= ks_lo && ks < ks_hi) {
        float f[8]; unpack8(cbf[ks], f);
        if (span8[ks] <= 40.f) {
          const float rowf = __expf(fminf(ci_ - cref8[ks], 80.f));
#pragma unroll
          for (int e = 0; e < 8; ++e) {
            const int j = ks * 16 + 8 * h + e;
            const bool ok = dir ? (j >= i) : (j <= i);
            f[e] = ok ? f[e] * rowf * dtv[j] : 0.f;
          }
        } else {
#pragma unroll
          for (int e = 0; e < 8; ++e) {
            const int j = ks * 16 + 8 * h + e;
            const bool ok = dir ? (j >= i) : (j <= i);
            f[e] = ok ? f[e] * __expf(fminf(ci_ - cum[j], 0.f)) * dtr[j] : 0.f;
          }
        }
        const bf16x8 af = __builtin_bit_cast(bf16x8, pack8(f));
#pragma unroll
        for (int nt = 0; nt < 2; ++nt) {
          const bf16x8 bfv = *(const bf16x8*)(sXT + (32 * nt + c) * 136 + ks * 16 + 8 * h);
          Y1[nt] = MFMA(af, bfv, Y1[nt]);
        }
      }
    }
#pragma unroll
    for (int nt = 0; nt < 2; ++nt)
#pragma unroll
      for (int r = 0; r < 16; ++r) {
        const int ir = 32 * w + crow(r, h), pc = 32 * nt + c;
        const float y = Y1[nt][r] + Dk * bf2f(sXT[pc * 136 + ir]);
        Y[(size_t)(t0 + ir) * LDA + head * 64 + pc] = f2bf(y);
      }
#pragma unroll
    for (int mt = 0; mt < 2; ++mt)
#pragma unroll
      for (int r = 0; r < 16; ++r) S[mt][r] *= dec;
#pragma unroll
    for (int ks = 0; ks < 8; ++ks) {
#pragma unroll
      for (int mt = 0; mt < 2; ++mt) {
        const bf16x8 af = *(const bf16x8*)(sXS + (32 * mt + c) * 136 + ks * 16 + 8 * h);
        S[mt] = MFMA(af, btf[ks], S[mt]);
      }
    }
    __syncthreads();
#pragma unroll
    for (int mt = 0; mt < 2; ++mt)
#pragma unroll
      for (int r = 0; r < 16; ++r) sHS[(32 * mt + crow(r, h)) * 136 + 32 * w + c] = f2bf(S[mt][r]);
  }
  if (!lat) {
    float* o = OUTP(p) + (dir ? O_SB : O_SF) + ((size_t)((sidx * 4 + l) * 16 + head) * 64) * 128;
#pragma unroll
    for (int mt = 0; mt < 2; ++mt)
#pragma unroll
      for (int r = 0; r < 16; ++r) o[(size_t)(32 * mt + crow(r, h)) * 128 + 32 * w + c] = S[mt][r];
  }
  __syncthreads();
}

DI void attn_item(const Params& p, int l, int item) {
  const int tid = TID(), lane = tid & 63, w = __builtin_amdgcn_readfirstlane(tid >> 6), h = lane >> 5, c = lane & 31;
  int hh, t0, Lk, krow0, pos0; size_t vbase; bool lat;
  if (item < 1024) { const int b = item >> 8; hh = (item >> 5) & 7; const int qb = item & 31; lat = true; t0 = TC + b * 4096 + qb * 128; Lk = LKL; krow0 = b * LKL; vbase = (size_t)b * 512 * LKL; pos0 = qb * 128; }
  else { const int it = item - 1024; const int s = it >> 4; hh = (it >> 1) & 7; const int qb = it & 1; lat = false; t0 = s * 256 + qb * 128; Lk = 256; krow0 = KROW_CTX + s * 256; vbase = (size_t)4 * 512 * LKL + (size_t)s * 512 * 256; pos0 = 0; }
  const u16* Q = (const u16*)(WSP(p) + WS_Q); const u16* KN = (const u16*)(WSP(p) + WS_KN); const u16* KRA = (const u16*)(WSP(p) + WS_KR);
  const u16* VT = (const u16*)(WSP(p) + WS_VT) + vbase + (size_t)hh * 64 * Lk;
  u16* YC = (u16*)(WSP(p) + WS_YC);
  u16* sK = (u16*)smem;
  u16* sV = sK + 2 * 64 * 104;
  bf16x8 qf[6];
  {
    const int tq = t0 + 32 * w + c;
    const u16* qrow = Q + (size_t)tq * 768 + hh * 96 + 8 * h;
    float f[6][8];
#pragma unroll
    for (int s = 0; s < 6; ++s) unpack8(*(const u32x4*)(qrow + 16 * s), f[s]);
    if (lat) {
      const int pos = pos0 + 32 * w + c;
#pragma unroll
      for (int e = 0; e < 8; ++e) {
        const int ii = 8 * h + e;
        const float pp = (ii < 8) ? (float)(pos >> 6) : (float)(pos & 63);
        const float inv = exp2f(-(float)(ii & 7) * (13.287712379549449f / 8.f));
        const float ang = pp * inv;
        const float cs = cosf(ang), sn = sinf(ang);
        const float x1 = f[4][e], x2 = f[5][e];
        f[4][e] = x1 * cs - x2 * sn; f[5][e] = x1 * sn + x2 * cs;
      }
    }
    const float sc = 0.10206207261596575f * 1.4426950408889634f;
#pragma unroll
    for (int s = 0; s < 6; ++s) {
#pragma unroll
      for (int e = 0; e < 8; ++e) f[s][e] *= sc;
      qf[s] = __builtin_bit_cast(bf16x8, pack8(f[s]));
    }
  }
  f32x16 O[2];
#pragma unroll
  for (int vt = 0; vt < 2; ++vt)
#pragma unroll
    for (int r = 0; r < 16; ++r) O[vt][r] = 0.f;
  float m_run = -1e30f, l_run = 0.f;
  const int ntile = Lk >> 6;
  u32x4 rk[3], rv[2];
  auto gload = [&](int kt) {
    const int key0 = kt * 64;
#pragma unroll
    for (int q = 0; q < 3; ++q) {
      const int id = tid + 256 * q, key = id / 12, cc = id - key * 12;
      const size_t kr = (size_t)(krow0 + key0 + key);
      rk[q] = cc < 8 ? *(const u32x4*)(KN + kr * 512 + hh * 64 + cc * 8) : *(const u32x4*)(KRA + kr * 32 + (cc - 8) * 8);
    }
#pragma unroll
    for (int q = 0; q < 2; ++q) {
      const int id = tid + 256 * q, v = id >> 3, cc = id & 7;
      rv[q] = *(const u32x4*)(VT + (size_t)v * Lk + key0 + cc * 8);
    }
  };
  auto sstore = [&](int buf) {
#pragma unroll
    for (int q = 0; q < 3; ++q) {
      const int id = tid + 256 * q, key = id / 12, cc = id - key * 12;
      *(u32x4*)(sK + buf * 64 * 104 + key * 104 + cc * 8) = rk[q];
    }
#pragma unroll
    for (int q = 0; q < 2; ++q) {
      const int id = tid + 256 * q, v = id >> 3, cc = id & 7;
      u16* d = sV + buf * 64 * 68 + v * 68 + cc * 8;
      u32x2 lo = {rv[q][0], rv[q][1]}, hi = {rv[q][2], rv[q][3]};
      *(u32x2*)d = lo; *(u32x2*)(d + 4) = hi;
    }
  };
  gload(0);
  __syncthreads();
  sstore(0);
  __syncthreads();
  for (int kt = 0; kt < ntile; ++kt) {
    const int cur = kt & 1;
    if (kt + 1 < ntile) gload(kt + 1);
    f32x16 Sx[2];
#pragma unroll
    for (int k2 = 0; k2 < 2; ++k2) {
#pragma unroll
      for (int r = 0; r < 16; ++r) Sx[k2][r] = 0.f;
      const u16* kp = sK + cur * 64 * 104 + (32 * k2 + c) * 104 + 8 * h;
#pragma unroll
      for (int s = 0; s < 6; ++s) Sx[k2] = MFMA(*(const bf16x8*)(kp + 16 * s), qf[s], Sx[k2]);
    }
    float mx = Sx[0][0];
#pragma unroll
    for (int k2 = 0; k2 < 2; ++k2)
#pragma unroll
      for (int r = 0; r < 16; ++r) mx = fmaxf(mx, Sx[k2][r]);
    mx = fmaxf(mx, __shfl_xor(mx, 32));
    const float m_new = fmaxf(m_run, mx);
    const float alpha = __builtin_amdgcn_exp2f(m_run - m_new);
    m_run = m_new;
    float ls = 0.f;
#pragma unroll
    for (int k2 = 0; k2 < 2; ++k2)
#pragma unroll
      for (int r = 0; r < 16; ++r) { const float pv = __builtin_amdgcn_exp2f(Sx[k2][r] - m_new); Sx[k2][r] = pv; ls += pv; }
    l_run = l_run * alpha + ls;
#pragma unroll
    for (int vt = 0; vt < 2; ++vt)
#pragma unroll
      for (int r = 0; r < 16; ++r) O[vt][r] *= alpha;
#pragma unroll
    for (int k2 = 0; k2 < 2; ++k2)
#pragma unroll
      for (int s2 = 0; s2 < 2; ++s2) {
        u32x4 pp;
        pp[0] = pk2(Sx[k2][8 * s2 + 0], Sx[k2][8 * s2 + 1]); pp[1] = pk2(Sx[k2][8 * s2 + 2], Sx[k2][8 * s2 + 3]);
        pp[2] = pk2(Sx[k2][8 * s2 + 4], Sx[k2][8 * s2 + 5]); pp[3] = pk2(Sx[k2][8 * s2 + 6], Sx[k2][8 * s2 + 7]);
        const bf16x8 pf = __builtin_bit_cast(bf16x8, pp);
#pragma unroll
        for (int vt = 0; vt < 2; ++vt) {
          const u16* vp = sV + cur * 64 * 68 + (32 * vt + c) * 68 + 32 * k2 + 16 * s2 + 4 * h;
          const u32x2 lo = *(const u32x2*)vp, hi = *(const u32x2*)(vp + 8);
          u32x4 vv = {lo[0], lo[1], hi[0], hi[1]};
          O[vt] = MFMA(__builtin_bit_cast(bf16x8, vv), pf, O[vt]);
        }
      }
    if (kt + 1 < ntile) sstore(cur ^ 1);
    __syncthreads();
  }
  const float lt = l_run + __shfl_xor(l_run, 32);
  const float invl = 1.f / lt;
  const int tq = t0 + 32 * w + c;
#pragma unroll
  for (int vt = 0; vt < 2; ++vt)
#pragma unroll
    for (int g = 0; g < 4; ++g) {
      u32x2 pk; pk[0] = pk2(O[vt][4 * g] * invl, O[vt][4 * g + 1] * invl); pk[1] = pk2(O[vt][4 * g + 2] * invl, O[vt][4 * g + 3] * invl);
      *(u32x2*)(YC + (size_t)tq * 512 + hh * 64 + 32 * vt + 8 * g + 4 * h) = pk;
    }
}

DI void l5_phase(const Params& p, int l, int rep = 0) {
  u32* ctr = (u32*)(WSP(p) + WS_CTR) + l + 8 * rep;
  int* sitem = (int*)(smem + 73728 - 16);
  constexpr int NITEMS = 128 + 1024 + 256 + 512;
  while (true) {
    __syncthreads();
    if (TID() == 0) *sitem = (int)atomicAdd(ctr, 1u);
    __syncthreads();
    const int it = *sitem;
    if (it >= NITEMS) break;
    if (it < 128) ssd_unit(p, l, it);
    else if (it < 128 + 1280) attn_item(p, l, it - 128);
    else ssd_unit(p, l, it - 1280);
  }
}

DI void l5b_phase(const Params& p, int l) {
  u16* ACT = (u16*)(WSP(p) + WS_ACT);
  float* RB = (float*)(WSP(p) + WS_RB);
  const int lane = TID() & 63, gw = BID() * 4 + (TID() >> 6), nwv = gridDim.x * 4;
  for (int t = gw; t < T; t += nwv) {
    u16* row = ACT + (size_t)t * LDA;
    float ss = 0.f;
#pragma unroll
    for (int q = 0; q < 2; ++q) {
      const int c8 = (lane + 64 * q) * 8;
      float yf[8], yb[8], z[8], o[8];
      unpack8(*(const u32x4*)(row + C_YF + c8), yf); unpack8(*(const u32x4*)(row + C_YB + c8), yb); unpack8(*(const u32x4*)(row + C_Z + c8), z);
#pragma unroll
      for (int e = 0; e < 8; ++e) { o[e] = (yf[e] + yb[e]) * silu_f(z[e]); ss += o[e] * o[e]; }
      *(u32x4*)(row + C_YF + c8) = pack8(o);
    }
    ss = wave_sum(ss);
    if (lane == 0) RB[t] = rsqrtf(ss * (1.f / 1024.f) + EPS);
  }
}

DI int gate_col(int n) { return n < 2048 ? n : 3584 + (n - 2048); }
DI void l6a_phase(const Params& p, int l, int& nbar) {
  constexpr int NT = 24, MT = 80;
  TILE_LOOP(MT * NT) {
    group_sync(p, nbar);
    if (idx >= MT * NT) continue;
    int mt, nt; decode_tile(idx, NT, mt, nt);
    const u16* W = (const u16*)(WSP(p) + WS_W) + W_GATE;
    const u16* H = (const u16*)(WSP(p) + WS_H);
    u16* ACT = (u16*)(WSP(p) + WS_ACT);
    f32x16 acc[8];
#pragma unroll
    for (int j = 0; j < 8; ++j)
#pragma unroll
      for (int r = 0; r < 16; ++r) acc[j][r] = 0.f;
    gemm_tile_wf8(W, 1024, nt * 128, H + (size_t)mt * 256 * 1024, 1024, acc);
    const int m0 = mt * 256, gc0 = gate_col(nt * 128);
    stage_bf16_w8([&](int j, int r) { return sigmoid_f(acc[j][r]); });
    copy_out_bf16_256x128(ACT + (size_t)m0 * LDA + gc0, LDA, 128);
  }
}
DI void l6b_phase(const Params& p, int l, int& nbar) {
  TILE_LOOP(160 * 8) {
    group_sync(p, nbar);
    if (idx >= 160 * 8) continue;
    int mt, nt; decode_tile(idx, 8, mt, nt);
    const int m0 = mt * 128, n0 = nt * 128;
    u32 Mp[2][2][8];
#pragma unroll
    for (int i = 0; i < 2; ++i)
#pragma unroll
      for (int j = 0; j < 2; ++j)
#pragma unroll
        for (int r = 0; r < 8; ++r) Mp[i][j][r] = 0u;
#pragma unroll 1
    for (int br = 0; br < 3; ++br) {
      const u16* W = (const u16*)(WSP(p) + WS_W);
      const u16* ACT = (const u16*)(WSP(p) + WS_ACT);
      f32x16 acc[2][2]; zero_acc(acc);
      const u16* Ab; const u16* Wb; int ldab, Kb;
      if (br == 0) { Ab = (const u16*)(WSP(p) + WS_YA) + (size_t)m0 * 512; ldab = 512; Wb = W + W_A + (size_t)n0 * 512; Kb = 512; }
      else if (br == 1) { Ab = ACT + (size_t)m0 * LDA + C_YF; ldab = LDA; Wb = W + W_B + (size_t)n0 * 1024; Kb = 1024; }
      else { Ab = (const u16*)(WSP(p) + WS_YC) + (size_t)m0 * 512; ldab = 512; Wb = W + W_C + (size_t)n0 * 512; Kb = 512; }
      gemm_tile(Wb, Kb, Ab, ldab, Kb, acc);
      const float* RB = (const float*)(WSP(p) + WS_RB);
      const int tid3 = TID(), lane3 = tid3 & 63, w3 = tid3 >> 6;
      const int wm = w3 >> 1, h = lane3 >> 5, wn = w3 & 1, c = lane3 & 31;
      const int gc0 = gate_col(br * 1024 + n0);
      u16* sG = (u16*)smem;
#pragma unroll
      for (int q = 0; q < 8; ++q) {
        const int id = tid3 + 256 * q, row = id >> 4, cc = id & 15;
        *(u32x4*)(sG + row * 136 + cc * 8) = *(const u32x4*)(ACT + (size_t)(m0 + row) * LDA + gc0 + cc * 8);
      }
      __syncthreads();
#pragma unroll
      for (int j = 0; j < 2; ++j) {
        const int ml = wn * 64 + j * 32 + c;
        const float rb = (br == 1) ? RB[m0 + ml] : 1.f;
#pragma unroll
        for (int i = 0; i < 2; ++i)
#pragma unroll
          for (int g = 0; g < 4; ++g) {
            const u32x2 gv = *(const u32x2*)(sG + ml * 136 + wm * 64 + i * 32 + 8 * g + 4 * h);
            const float v0 = acc[i][j][4 * g] * rb, v1 = acc[i][j][4 * g + 1] * rb, v2 = acc[i][j][4 * g + 2] * rb, v3 = acc[i][j][4 * g + 3] * rb;
            Mp[i][j][2 * g] = pk2(bflo(Mp[i][j][2 * g]) + bflo(gv[0]) * v0, bfhi(Mp[i][j][2 * g]) + bfhi(gv[0]) * v1);
            Mp[i][j][2 * g + 1] = pk2(bflo(Mp[i][j][2 * g + 1]) + bflo(gv[1]) * v2, bfhi(Mp[i][j][2 * g + 1]) + bfhi(gv[1]) * v3);
          }
      }
    }
    {
      u16* MG = (u16*)(WSP(p) + WS_XT);
      u16* sC = (u16*)smem;
      const int tid4 = TID(), lane4 = tid4 & 63, w4 = tid4 >> 6;
      const int wm = w4 >> 1, h = lane4 >> 5, wn = w4 & 1, c = lane4 & 31;
      __syncthreads();
#pragma unroll
      for (int i = 0; i < 2; ++i)
#pragma unroll
        for (int j = 0; j < 2; ++j)
#pragma unroll
          for (int g = 0; g < 4; ++g) {
            u32x2 pk; pk[0] = Mp[i][j][2 * g]; pk[1] = Mp[i][j][2 * g + 1];
            *(u32x2*)(sC + (wn * 64 + j * 32 + c) * 136 + wm * 64 + i * 32 + 8 * g + 4 * h) = pk;
          }
      __syncthreads();
      copy_out_bf16<128>(MG + (size_t)m0 * 1024 + n0, 1024, 128);
    }
  }
}

DI void resid_gemm_phase(const Params& p, int l, const u16* A, int lda, const u16* Wm, int K, int gidx, int& nbar) {
  float* X = OUTP(p);
  const float* MOD = (const float*)(WSP(p) + WS_MOD) + (size_t)l * 5 * 6144 + gidx * 1024;
  constexpr int NFULL = 1024, NITEM = 1024 + 512;
  TILE_LOOP(NITEM) {
    group_sync(p, nbar);
    if (idx >= NITEM) continue;
    const bool split = idx >= NFULL;
    const int tile = split ? NFULL + ((idx - NFULL) >> 1) : idx;
    const int half = split ? ((idx - NFULL) & 1) : 0;
    const int Kp = split ? (K >> 1) : K;
    int mt, nt; decode_tile(tile, 8, mt, nt);
    const int m0 = mt * 128, n0 = nt * 128;
    f32x16 acc[4];
#pragma unroll
    for (int j = 0; j < 4; ++j)
#pragma unroll
      for (int r = 0; r < 16; ++r) acc[j][r] = 0.f;
    gemm_tile_wf4(Wm, K, n0, A + (size_t)m0 * lda + half * Kp, lda, acc, Kp, (half * Kp) >> 4);
    const float* gt = MOD + tile_cb(mt) * 6144 + n0;
    stage_f32_w4(acc);
    {
      const float* sC = (const float*)smem;
      const int tid = TID(), cc = tid & 31;
      const f4 g4 = *(const f4*)(gt + cc * 4);
#pragma unroll 4
      for (int q = 0; q < 16; ++q) {
        const int row = (tid >> 5) + 8 * q;
        const f4 v = *(const f4*)(sC + row * 132 + cc * 4);
        float* xp = X + (size_t)(m0 + row) * 1024 + n0 + cc * 4;
        if (!split) { f4 x = *(const f4*)xp; x[0] += g4[0] * v[0]; x[1] += g4[1] * v[1]; x[2] += g4[2] * v[2]; x[3] += g4[3] * v[3]; *(f4*)xp = x; }
        else { atomicAdd(xp, g4[0] * v[0]); atomicAdd(xp + 1, g4[1] * v[1]); atomicAdd(xp + 2, g4[2] * v[2]); atomicAdd(xp + 3, g4[3] * v[3]); }
      }
    }
  }
}

template <int MODE = 0>
DI void l9_phase(const Params& p, int l, int& nbar) {
  const u16* W = (const u16*)(WSP(p) + WS_W) + W_F13;
  const u16* H = (const u16*)(WSP(p) + WS_H);
  u16* ACT = (u16*)(WSP(p) + WS_ACT);
  constexpr int NT = 44, MT = 80;
  TILE_LOOP(MT * NT) {
    group_sync(p, nbar);
    if (idx >= MT * NT) continue;
    int mt, nt; decode_tile(idx, NT, mt, nt);
    f32x16 acc[8];
#pragma unroll
    for (int j = 0; j < 8; ++j)
#pragma unroll
      for (int r = 0; r < 16; ++r) acc[j][r] = 0.f;
    gemm_tile_wf8(W, 1024, nt * 128, H + (size_t)mt * 256 * 1024, 1024, acc);
    stage_bf16_w8u([&](int j, int r) { return silu_f(acc[j][r]) * acc[j][r + 8]; });
    if (MODE == 0) copy_out_bf16_256x64(ACT + (size_t)mt * 256 * LDA + C_U + nt * 64, LDA);
  }
}

DI void final_phase(const Params& p) {
  float* X = OUTP(p);
  const float* nw = INP(p, I_FNW);
  const int lane = TID() & 63, gw = BID() * 4 + (TID() >> 6), nwv = gridDim.x * 4;
  for (int t = gw; t < T; t += nwv) {
    f4* xr = (f4*)(X + (size_t)t * 1024) + lane;
    f4 v[4]; float s = 0.f;
#pragma unroll
    for (int j = 0; j < 4; ++j) { v[j] = xr[64 * j]; s += v[j][0] * v[j][0] + v[j][1] * v[j][1] + v[j][2] * v[j][2] + v[j][3] * v[j][3]; }
    const float rstd = rsqrtf(wave_sum(s) * (1.f / 1024.f) + EPS);
#pragma unroll
    for (int j = 0; j < 4; ++j) {
      const f4 wv = *(const f4*)(nw + 4 * lane + 256 * j);
      f4 o; o[0] = v[j][0] * rstd * wv[0]; o[1] = v[j][1] * rstd * wv[1]; o[2] = v[j][2] * rstd * wv[2]; o[3] = v[j][3] * rstd * wv[3];
      xr[64 * j] = o;
    }
  }
}

constexpr int NPH_LAYER = 11;
constexpr int NPHASE = 1 + NLAYER * NPH_LAYER + 1;

DI void run_phase(const Params& p, int ph) {
  int nbar = 0;
  if (ph == 0) { pre_phase(p); return; }
  if (ph == NPHASE - 1) { final_phase(p); return; }
  const int l = (ph - 1) / NPH_LAYER, s = (ph - 1) % NPH_LAYER;
  const u16* W = (const u16*)(WSP(p) + WS_W);
  const u16* ACT = (const u16*)(WSP(p) + WS_ACT);
  switch (s) {
    case 0: l1_phase(p, l); break;
    case 1: l2_phase(p, l, nbar); break;
    case 2: l3_phase(p, l); break;
    case 3: l4_phase(p, l, nbar); break;
    case 4: l5_phase(p, l); break;
    case 5: l5b_phase(p, l); break;
    case 6: l6a_phase(p, l, nbar); l6b_phase(p, l, nbar); break;
    case 7: resid_gemm_phase(p, l, (const u16*)(WSP(p) + WS_XT), 1024, W + W_O, 1024, 2, nbar); break;
    case 8: norm_phase(p, l, 1); break;
    case 9: l9_phase(p, l, nbar); break;
    case 10: resid_gemm_phase(p, l, ACT + C_U, LDA, W + W_F2, FF, 5, nbar); break;
  }
}

__global__ void __launch_bounds__(256, 2) fwd_kernel(Params p) {
#if MULTI
  run_phase(p, p.ph_lo);
#else
  cg::grid_group grid = cg::this_grid();
  if (threadIdx.x == 0) xb_words = make_uint4(0u, 0u, 0u, 0u);
  __syncthreads();
  if (threadIdx.x == 0) (void)xb_add(&((unsigned*)(WSP(p) + WS_BAR))[XB_XCNT(xb_xcc_id())], 1u);
  if (p.ph_lo < 0) grid.sync();
  int nbar = 0;
  pre_phase(p); gsync(p);
#pragma unroll 1
  for (int l = 0; l < NLAYER; ++l) {
    l1_phase(p, l); gsync(p);
    if (PROBE_DUP == 1) { l1_phase(p, l); gsync(p); }
    l2_phase(p, l, nbar); gsync(p);
    if (PROBE_DUP == 2) { l2_phase(p, l, nbar); gsync(p); }
    l3_phase(p, l); l3d_phase(p, l); gsync(p);
    if (PROBE_DUP == 3) { l3_phase(p, l); gsync(p); }
    l4_phase(p, l, nbar); gsync(p);
    if (PROBE_DUP == 4) { l4_phase(p, l, nbar); gsync(p); }
    l5_phase(p, l); gsync(p);
    if (PROBE_DUP == 5) { l5_phase(p, l, 1); gsync(p); }
    l5b_phase(p, l); gsync(p);
    l6a_phase(p, l, nbar); gsync(p);
    l6b_phase(p, l, nbar); gsync(p);
    resid_gemm_phase(p, l, (const u16*)(WSP(p) + WS_XT), 1024, (const u16*)(WSP(p) + WS_W) + W_O, 1024, 2, nbar); gsync(p);
    norm_phase(p, l, 1); gsync(p);
    l9_phase(p, l, nbar); gsync(p);
    if (PROBE_DUP == 9) { l9_phase<GEMM_MODE_PROBE>(p, l, nbar); gsync(p); }
    resid_gemm_phase(p, l, (const u16*)(WSP(p) + WS_ACT) + C_U, LDA, (const u16*)(WSP(p) + WS_W) + W_F2, FF, 5, nbar); gsync(p);
  }
  final_phase(p);
#endif
}

extern "C" void kernel_launch(void* const* d_in, const int* in_sizes, int n_in, void* d_out, int out_size, void* d_ws, size_t ws_size,
                              hipStream_t stream) {
  static int grid_blocks = 0;
  if (!grid_blocks) {
    int dev = 0, cus = 0, per_cu = 0;
    hipGetDevice(&dev);
    hipDeviceGetAttribute(&cus, hipDeviceAttributeMultiprocessorCount, dev);
    hipOccupancyMaxActiveBlocksPerMultiprocessor(&per_cu, fwd_kernel, 256, 0);
    per_cu = 2;
    grid_blocks = cus * per_cu;
    if (ws_size < WS_END || n_in != 32) { fprintf(stderr, "kernel_launch: ws too small (%zu < %zu) or n_in %d\n", ws_size, (size_t)WS_END, n_in); grid_blocks = -1; }
  }
  if (grid_blocks < 0) return;
  Params p{};
  for (int i = 0; i < 32; ++i) p.in[i] = (const float*)d_in[i];
  p.in[32] = (const float*)d_out;
  p.in[33] = (const float*)d_ws;
#if MULTI
  for (int ph = 0; ph < NPHASE; ++ph) {
    p.ph_lo = ph; p.ph_hi = ph + 1;
    hipLaunchKernelGGL(fwd_kernel, dim3(grid_blocks), dim3(256), 0, stream, p);
  }
#else
  p.ph_lo = 0; p.ph_hi = NPHASE;
  (void)hipMemsetAsync((char*)d_ws + WS_BAR, 0, 16384, stream);
  void* args[] = {&p};
  hipError_t e = hipLaunchCooperativeKernel((void*)fwd_kernel, dim3(grid_blocks), dim3(256), args, 0, stream);
  if (e != hipSuccess) fprintf(stderr, "cooperative launch failed: %s (grid %d)\n", hipGetErrorString(e), grid_blocks);
#endif
}
```

```cpp
#include <hip/hip_runtime.h>
#include <hip/hip_cooperative_groups.h>
#include <cstdio>
namespace cg = cooperative_groups;

#ifndef PROBE_DUP
#define PROBE_DUP 0
#endif
#ifndef USE_GSYNC
#define USE_GSYNC 0
#endif
#ifndef GEMM_MODE_PROBE
#define GEMM_MODE_PROBE 1
#endif
#ifndef MULTI
#define MULTI 0
#endif

#define DI __device__ __forceinline__
typedef unsigned short u16;
typedef unsigned int u32;
using bf16x8 = __attribute__((ext_vector_type(8))) short;
using f32x16 = __attribute__((ext_vector_type(16))) float;
using u32x4 = __attribute__((ext_vector_type(4))) unsigned;
using u32x2 = __attribute__((ext_vector_type(2))) unsigned;
using f4 = __attribute__((ext_vector_type(4))) float;
typedef __bf16 bf2_t __attribute__((ext_vector_type(2)));
typedef float f2_t __attribute__((ext_vector_type(2)));
#define MFMA(a, b, c) __builtin_amdgcn_mfma_f32_32x32x16_bf16((a), (b), (c), 0, 0, 0)

constexpr int D = 1024, T = 20480, TC = 4096, NLAYER = 4;
constexpr int NPROJ = 4656, INC = 7728, FF = 2816;
constexpr int LDA = 4672;
constexpr int C_AX = 0, C_AB = 512, C_AC = 1024, C_Z = 1536, C_XBC = 2560, C_DT = 4096, C_CQ = 4112, C_CKV = 4368, C_KR = 4624;
constexpr int C_YF = C_XBC, C_YB = 0, C_MERGED = 0, C_U = 0;
constexpr int NKROW = 22528, KROW_CTX = 18432, LKL = 4608;
constexpr float EPS = 1e-6f;

constexpr size_t W_IN = 0;
constexpr size_t W_GATE = W_IN + (size_t)4736 * 1024;
constexpr size_t W_A = W_GATE + (size_t)3072 * 1024;
constexpr size_t W_B = W_A + 1024 * 512;
constexpr size_t W_UQ = W_B + 1024 * 1024;
constexpr size_t W_UKV = W_UQ + 768 * 256;
constexpr size_t W_C = W_UKV + 1024 * 256;
constexpr size_t W_O = W_C + 1024 * 512;
constexpr size_t W_F13 = W_O + 1024 * 1024;
constexpr size_t W_F2 = W_F13 + (size_t)2 * FF * 1024;
constexpr size_t W_END = W_F2 + (size_t)1024 * FF;

constexpr size_t al256(size_t x) { return (x + 255) & ~(size_t)255; }
constexpr size_t WS_W = 0;
constexpr size_t WS_ACT = al256(WS_W + W_END * 2);
constexpr size_t WS_H = al256(WS_ACT + (size_t)T * LDA * 2);
constexpr size_t WS_XT = al256(WS_H + (size_t)T * 1024 * 2);
constexpr size_t WS_BCP = al256(WS_XT + (size_t)T * 1024 * 2);
constexpr size_t WS_BT = al256(WS_BCP + (size_t)T * 512 * 2);
constexpr size_t WS_YA = al256(WS_BT + (size_t)160 * 256 * 128 * 2);
constexpr size_t WS_YC = al256(WS_YA + (size_t)T * 512 * 2);
constexpr size_t WS_Q = al256(WS_YC + (size_t)T * 512 * 2);
constexpr size_t WS_KN = al256(WS_Q + (size_t)T * 768 * 2);
constexpr size_t WS_VT = al256(WS_KN + (size_t)NKROW * 512 * 2);
constexpr size_t WS_KR = al256(WS_VT + (size_t)NKROW * 512 * 2);
constexpr size_t WS_CKVA = al256(WS_KR + (size_t)NKROW * 32 * 2);
constexpr size_t WS_CB = al256(WS_CKVA + (size_t)NKROW * 256 * 2);
constexpr size_t WS_DT = al256(WS_CB + (size_t)320 * 128 * 128 * 2);
constexpr size_t WS_RQ = al256(WS_DT + (size_t)T * 16 * 4);
constexpr size_t WS_RB = al256(WS_RQ + (size_t)T * 4);
constexpr size_t WS_MOD = al256(WS_RB + (size_t)T * 4);
constexpr size_t WS_CTR = al256(WS_MOD + (size_t)NLAYER * 5 * 6144 * 4);
constexpr size_t WS_CUMS = al256(WS_CTR + 4096);
constexpr size_t WS_BAR = al256(WS_CUMS + (size_t)160 * 2 * 16 * 768 * 4);
constexpr size_t WS_END = WS_BAR + 16384;

constexpr size_t O_CKV = 20971520, O_KR = 25165824, O_SF = 25690112, O_SB = 34078720;

struct Params {
  const float* in[34];
  int ph_lo, ph_hi;
};
enum { I_XP = 0, I_XS, I_C, I_CCKV, I_CKR, I_STF, I_STB, I_CCTX, I_WIN, I_ACW, I_WAO, I_SCW, I_SCB, I_ALOG, I_DTB, I_SD, I_SNW, I_WBO,
       I_QNW, I_WUQ, I_KVNW, I_WUKV, I_WCO, I_WO, I_WADA, I_BADA, I_N1, I_N2, I_F1, I_F3, I_F2, I_FNW };

DI int TID() { int t = threadIdx.x; asm volatile("" : "+v"(t)); return t; }
DI int BID() { int b = blockIdx.x; asm volatile("" : "+s"(b)); return b; }
DI const float* KARG(int i) {
  unsigned long long kp = (unsigned long long)__builtin_amdgcn_kernarg_segment_ptr();
  asm volatile("" : "+s"(kp));
  typedef __attribute__((address_space(4))) const unsigned long long* karg_ptr_t;
  typedef __attribute__((address_space(1))) const float* gptr_t;
  return (const float*)(gptr_t)(((karg_ptr_t)kp)[i]);
}
DI unsigned char* WSP(const Params& p) { return (unsigned char*)KARG(33); }
DI float* OUTP(const Params& p) { return (float*)KARG(32); }
DI const float* INP(const Params& p, int i) { return KARG(i); }
DI float bf2f(u16 v) { return __uint_as_float((u32)v << 16); }
DI float bflo(u32 v) { return __uint_as_float(v << 16); }
DI float bfhi(u32 v) { return __uint_as_float(v & 0xffff0000u); }
DI u32 pk2(float a, float b) { f2_t v = {a, b}; bf2_t r = __builtin_convertvector(v, bf2_t); return __builtin_bit_cast(u32, r); }
DI u16 f2bf(float a) { return (u16)(pk2(a, 0.f) & 0xffffu); }
DI float silu_f(float x) { return x / (1.f + __expf(-x)); }
DI float sigmoid_f(float x) { return 1.f / (1.f + __expf(-x)); }
DI float wave_sum(float v) {
#pragma unroll
  for (int o = 1; o < 64; o <<= 1) v += __shfl_xor(v, o);
  return v;
}
DI int crow(int r, int h) { return (r & 3) + 8 * (r >> 2) + 4 * h; }
DI int tile_cb(int mt) { return mt < 32 ? 0 : 1 + ((mt - 32) >> 5); }

__shared__ __attribute__((aligned(16))) unsigned char smem[73728];

template <int MODE = 0>
DI void gemm_tile(const u16* A, int lda, const u16* B, int ldb, int K, f32x16 (&acc)[2][2]) {
  u16* sA = (u16*)smem;
  u16* sB = sA + 2 * 128 * 72;
  const int tid = TID(), lane = tid & 63, w = tid >> 6, wm = w >> 1, wn = w & 1;
  const int lr = tid >> 3, lc = (tid & 7) * 8;
  const u16* ga = A + (size_t)lr * lda + lc;
  const u16* gb = B + (size_t)lr * ldb + lc;
  u32x4 ra[4], rb[4];
#pragma unroll
  for (int p = 0; p < 4; ++p) { ra[p] = *(const u32x4*)(ga + (size_t)(32 * p) * lda); rb[p] = *(const u32x4*)(gb + (size_t)(32 * p) * ldb); }
  __syncthreads();
#pragma unroll
  for (int p = 0; p < 4; ++p) { *(u32x4*)(sA + (lr + 32 * p) * 72 + lc) = ra[p]; *(u32x4*)(sB + (lr + 32 * p) * 72 + lc) = rb[p]; }
  __syncthreads();
  const int nk = K >> 6;
  const int fo_a = (wm * 64 + (lane & 31)) * 72 + (lane >> 5) * 8;
  const int fo_b = (wn * 64 + (lane & 31)) * 72 + (lane >> 5) * 8;
  for (int kt = 0; kt < nk; ++kt) {
    const int cur = kt & 1;
    if (kt + 1 < nk) {
      const int k0 = (kt + 1) * 64;
#pragma unroll
      for (int p = 0; p < 4; ++p) { ra[p] = *(const u32x4*)(ga + (size_t)(32 * p) * lda + k0); rb[p] = *(const u32x4*)(gb + (size_t)(32 * p) * ldb + k0); }
    }
    const u16* pa = sA + cur * 128 * 72 + fo_a;
    const u16* pb = sB + cur * 128 * 72 + fo_b;
#pragma unroll
    for (int ks = 0; ks < 4; ++ks) {
      bf16x8 a0 = *(const bf16x8*)(pa + ks * 16), a1 = *(const bf16x8*)(pa + 32 * 72 + ks * 16);
      bf16x8 b0 = *(const bf16x8*)(pb + ks * 16), b1 = *(const bf16x8*)(pb + 32 * 72 + ks * 16);
      acc[0][0] = MFMA(a0, b0, acc[0][0]); acc[0][1] = MFMA(a0, b1, acc[0][1]);
      acc[1][0] = MFMA(a1, b0, acc[1][0]); acc[1][1] = MFMA(a1, b1, acc[1][1]);
    }
    if (kt + 1 < nk) {
      u16* da = sA + (cur ^ 1) * 128 * 72; u16* db = sB + (cur ^ 1) * 128 * 72;
#pragma unroll
      for (int p = 0; p < 4; ++p) { *(u32x4*)(da + (lr + 32 * p) * 72 + lc) = ra[p]; *(u32x4*)(db + (lr + 32 * p) * 72 + lc) = rb[p]; }
    }
    __syncthreads();
  }
}

template <int MODE = 0>
DI void gemm_tile_wf(const u16* Wfm, int K, int nrow0, const u16* Act, int ldact, f32x16 (&acc)[2][2]) {
  u16* sB = (u16*)smem;
  const int tid = TID(), lane = tid & 63, w = tid >> 6, wm = w >> 1, wn = w & 1;
  const int lr = tid >> 3, lc = (tid & 7) * 8;
  const u16* gb = Act + (size_t)lr * ldact + lc;
  const size_t sb32 = (size_t)32 * ldact;
  const int kq = K >> 4;
  const u16* gw0 = Wfm + ((size_t)((nrow0 >> 5) + wm * 2) * kq) * 512 + lane * 8;
  const u16* gw1 = gw0 + (size_t)kq * 512;
  const int so = lr * 72 + lc;
  const int nk = K >> 6;
  u32x4 rb[4];
  bf16x8 wa[2][4], wb[2][4];
#pragma unroll
  for (int p = 0; p < 4; ++p) rb[p] = *(const u32x4*)(gb + p * sb32);
#pragma unroll
  for (int ks = 0; ks < 4; ++ks) { wa[0][ks] = *(const bf16x8*)(gw0 + ks * 512); wa[1][ks] = *(const bf16x8*)(gw1 + ks * 512); }
  __syncthreads();
#pragma unroll
  for (int p = 0; p < 4; ++p) *(u32x4*)(sB + so + 32 * 72 * p) = rb[p];
  __syncthreads();
  const int fo_b = (wn * 64 + (lane & 31)) * 72 + (lane >> 5) * 8;
  auto compute = [&](int cur, bf16x8 (&wf)[2][4]) {
    const u16* pb = sB + cur * 128 * 72 + fo_b;
#pragma unroll
    for (int ks = 0; ks < 4; ++ks) {
      const bf16x8 b0 = *(const bf16x8*)(pb + ks * 16), b1 = *(const bf16x8*)(pb + 32 * 72 + ks * 16);
      acc[0][0] = MFMA(wf[0][ks], b0, acc[0][0]); acc[0][1] = MFMA(wf[0][ks], b1, acc[0][1]);
      acc[1][0] = MFMA(wf[1][ks], b0, acc[1][0]); acc[1][1] = MFMA(wf[1][ks], b1, acc[1][1]);
    }
  };
  for (int kt = 0; kt < nk; kt += 2) {
    {
      const int k0 = (kt + 1) * 64;
#pragma unroll
      for (int p = 0; p < 4; ++p) rb[p] = *(const u32x4*)(gb + p * sb32 + k0);
#pragma unroll
      for (int ks = 0; ks < 4; ++ks) { wb[0][ks] = *(const bf16x8*)(gw0 + ((kt + 1) * 4 + ks) * 512); wb[1][ks] = *(const bf16x8*)(gw1 + ((kt + 1) * 4 + ks) * 512); }
    }
    compute(0, wa);
#pragma unroll
    for (int p = 0; p < 4; ++p) *(u32x4*)(sB + 128 * 72 + so + 32 * 72 * p) = rb[p];
    __syncthreads();
    {
      const int kn = (kt + 2 < nk) ? kt + 2 : nk - 1;
#pragma unroll
      for (int p = 0; p < 4; ++p) rb[p] = *(const u32x4*)(gb + p * sb32 + kn * 64);
#pragma unroll
      for (int ks = 0; ks < 4; ++ks) { wa[0][ks] = *(const bf16x8*)(gw0 + (kn * 4 + ks) * 512); wa[1][ks] = *(const bf16x8*)(gw1 + (kn * 4 + ks) * 512); }
    }
    compute(1, wb);
    if (kt + 2 < nk) {
#pragma unroll
      for (int p = 0; p < 4; ++p) *(u32x4*)(sB + so + 32 * 72 * p) = rb[p];
    }
    __syncthreads();
  }
}

DI void gemm_tile_wf4(const u16* Wfm, int K, int nrow0, const u16* Act, int ldact, f32x16 (&acc)[4], int Kp = 0, int ks0 = 0) {
  u16* sB = (u16*)smem;
  const int tid = TID(), lane = tid & 63, w = tid >> 6;
  const int lr = tid >> 3, lc = (tid & 7) * 8;
  const u16* gb = Act + (size_t)lr * ldact + lc;
  const size_t sb32 = (size_t)32 * ldact;
  const int kq = K >> 4;
  const u16* gw = Wfm + ((size_t)((nrow0 >> 5) + w) * kq + ks0) * 512 + lane * 8;
  const int so = lr * 72 + lc;
  const int nk = (Kp ? Kp : K) >> 6;
  u32x4 rb[4];
  bf16x8 wa[4], wb[4];
#pragma unroll
  for (int p = 0; p < 4; ++p) rb[p] = *(const u32x4*)(gb + p * sb32);
#pragma unroll
  for (int ks = 0; ks < 4; ++ks) wa[ks] = *(const bf16x8*)(gw + ks * 512);
  __syncthreads();
#pragma unroll
  for (int p = 0; p < 4; ++p) *(u32x4*)(sB + so + 32 * 72 * p) = rb[p];
  __syncthreads();
  const int fo_b = (lane & 31) * 72 + (lane >> 5) * 8;
  auto compute = [&](int cur, bf16x8 (&wf)[4]) {
    const u16* pb = sB + cur * 128 * 72 + fo_b;
#pragma unroll
    for (int ks = 0; ks < 4; ++ks) {
#pragma unroll
      for (int j = 0; j < 4; ++j) acc[j] = MFMA(wf[ks], *(const bf16x8*)(pb + j * 32 * 72 + ks * 16), acc[j]);
    }
  };
  for (int kt = 0; kt < nk; kt += 2) {
    {
      const int k0 = (kt + 1) * 64;
#pragma unroll
      for (int p = 0; p < 4; ++p) rb[p] = *(const u32x4*)(gb + p * sb32 + k0);
#pragma unroll
      for (int ks = 0; ks < 4; ++ks) wb[ks] = *(const bf16x8*)(gw + ((kt + 1) * 4 + ks) * 512);
    }
    compute(0, wa);
#pragma unroll
    for (int p = 0; p < 4; ++p) *(u32x4*)(sB + 128 * 72 + so + 32 * 72 * p) = rb[p];
    __syncthreads();
    {
      const int kn = (kt + 2 < nk) ? kt + 2 : nk - 1;
#pragma unroll
      for (int p = 0; p < 4; ++p) rb[p] = *(const u32x4*)(gb + p * sb32 + kn * 64);
#pragma unroll
      for (int ks = 0; ks < 4; ++ks) wa[ks] = *(const bf16x8*)(gw + (kn * 4 + ks) * 512);
    }
    compute(1, wb);
    if (kt + 2 < nk) {
#pragma unroll
      for (int p = 0; p < 4; ++p) *(u32x4*)(sB + so + 32 * 72 * p) = rb[p];
    }
    __syncthreads();
  }
}

DI void gemm_tile_wf8(const u16* Wfm, int K, int nrow0, const u16* Act, int ldact, f32x16 (&acc)[8]) {
  u16* sB = (u16*)smem;
  const int tid = TID(), lane = tid & 63, w = tid >> 6;
  const int lr = tid >> 3, lc = (tid & 7) * 8;
  const u16* gb = Act + (size_t)lr * ldact + lc;
  const size_t sb32 = (size_t)32 * ldact;
  const int kq = K >> 4;
  const u16* gw = Wfm + ((size_t)((nrow0 >> 5) + w) * kq) * 512 + lane * 8;
  const int so = lr * 72 + lc;
  const int nk = K >> 6;
  u32x4 rb[8];
  bf16x8 wa[4], wb[4];
#pragma unroll
  for (int p = 0; p < 8; ++p) rb[p] = *(const u32x4*)(gb + p * sb32);
#pragma unroll
  for (int ks = 0; ks < 4; ++ks) wa[ks] = *(const bf16x8*)(gw + ks * 512);
  __syncthreads();
#pragma unroll
  for (int p = 0; p < 8; ++p) *(u32x4*)(sB + so + 32 * 72 * p) = rb[p];
  __syncthreads();
  const int fo_b = (lane & 31) * 72 + (lane >> 5) * 8;
  auto compute = [&](int cur, bf16x8 (&wf)[4]) {
    const u16* pb = sB + cur * 256 * 72 + fo_b;
#pragma unroll
    for (int ks = 0; ks < 4; ++ks) {
#pragma unroll
      for (int j = 0; j < 8; ++j) acc[j] = MFMA(wf[ks], *(const bf16x8*)(pb + j * 32 * 72 + ks * 16), acc[j]);
    }
  };
  for (int kt = 0; kt < nk; kt += 2) {
    {
      const int k0 = (kt + 1) * 64;
#pragma unroll
      for (int p = 0; p < 8; ++p) rb[p] = *(const u32x4*)(gb + p * sb32 + k0);
#pragma unroll
      for (int ks = 0; ks < 4; ++ks) wb[ks] = *(const bf16x8*)(gw + ((kt + 1) * 4 + ks) * 512);
    }
    compute(0, wa);
#pragma unroll
    for (int p = 0; p < 8; ++p) *(u32x4*)(sB + 256 * 72 + so + 32 * 72 * p) = rb[p];
    __syncthreads();
    {
      const int kn = (kt + 2 < nk) ? kt + 2 : nk - 1;
#pragma unroll
      for (int p = 0; p < 8; ++p) rb[p] = *(const u32x4*)(gb + p * sb32 + kn * 64);
#pragma unroll
      for (int ks = 0; ks < 4; ++ks) wa[ks] = *(const bf16x8*)(gw + (kn * 4 + ks) * 512);
    }
    compute(1, wb);
    if (kt + 2 < nk) {
#pragma unroll
      for (int p = 0; p < 8; ++p) *(u32x4*)(sB + so + 32 * 72 * p) = rb[p];
    }
    __syncthreads();
  }
}

template <class F> DI void stage_bf16_w8(F f) {
  u16* sC = (u16*)smem;
  const int lane = TID() & 63, w = TID() >> 6, h = lane >> 5, c = lane & 31;
#pragma unroll
  for (int j = 0; j < 8; ++j)
#pragma unroll
    for (int g = 0; g < 4; ++g) {
      u32x2 pk; pk[0] = pk2(f(j, 4 * g), f(j, 4 * g + 1)); pk[1] = pk2(f(j, 4 * g + 2), f(j, 4 * g + 3));
      *(u32x2*)(sC + (j * 32 + c) * 136 + w * 32 + 8 * g + 4 * h) = pk;
    }
  __syncthreads();
}
DI void copy_out_bf16_256x128(u16* dst, size_t ld, int valid) {
  const u16* sC = (const u16*)smem;
  const int tid = TID();
#pragma unroll
  for (int q = 0; q < 16; ++q) {
    const int id = tid + 256 * q, row = id >> 4, cc = id & 15;
    if (cc * 8 < valid) *(u32x4*)(dst + (size_t)row * ld + cc * 8) = *(const u32x4*)(sC + row * 136 + cc * 8);
  }
}
template <class F> DI void stage_bf16_w8u(F f) {
  u16* sC = (u16*)smem;
  const int lane = TID() & 63, w = TID() >> 6, h = lane >> 5, c = lane & 31;
#pragma unroll
  for (int j = 0; j < 8; ++j)
#pragma unroll
    for (int g = 0; g < 2; ++g) {
      u32x2 pk; pk[0] = pk2(f(j, 4 * g), f(j, 4 * g + 1)); pk[1] = pk2(f(j, 4 * g + 2), f(j, 4 * g + 3));
      *(u32x2*)(sC + (j * 32 + c) * 72 + w * 16 + 8 * g + 4 * h) = pk;
    }
  __syncthreads();
}
DI void copy_out_bf16_256x64(u16* dst, size_t ld) {
  const u16* sC = (const u16*)smem;
  const int tid = TID();
#pragma unroll
  for (int q = 0; q < 8; ++q) {
    const int id = tid + 256 * q, row = id >> 3, cc = id & 7;
    *(u32x4*)(dst + (size_t)row * ld + cc * 8) = *(const u32x4*)(sC + row * 72 + cc * 8);
  }
}
template <class F> DI void stage_bf16_w4(F f) {
  u16* sC = (u16*)smem;
  const int lane = TID() & 63, w = TID() >> 6, h = lane >> 5, c = lane & 31;
#pragma unroll
  for (int j = 0; j < 4; ++j)
#pragma unroll
    for (int g = 0; g < 4; ++g) {
      u32x2 pk; pk[0] = pk2(f(j, 4 * g), f(j, 4 * g + 1)); pk[1] = pk2(f(j, 4 * g + 2), f(j, 4 * g + 3));
      *(u32x2*)(sC + (j * 32 + c) * 136 + w * 32 + 8 * g + 4 * h) = pk;
    }
  __syncthreads();
}

template <class F> DI void stage_bf16_w4u(F f) {
  u16* sC = (u16*)smem;
  const int lane = TID() & 63, w = TID() >> 6, h = lane >> 5, c = lane & 31;
#pragma unroll
  for (int j = 0; j < 4; ++j)
#pragma unroll
    for (int g = 0; g < 2; ++g) {
      u32x2 pk; pk[0] = pk2(f(j, 4 * g), f(j, 4 * g + 1)); pk[1] = pk2(f(j, 4 * g + 2), f(j, 4 * g + 3));
      *(u32x2*)(sC + (j * 32 + c) * 72 + w * 16 + 8 * g + 4 * h) = pk;
    }
  __syncthreads();
}
DI void stage_f32_w4(f32x16 (&acc)[4]) {
  float* sC = (float*)smem;
  const int lane = TID() & 63, w = TID() >> 6, h = lane >> 5, c = lane & 31;
#pragma unroll
  for (int j = 0; j < 4; ++j)
#pragma unroll
    for (int g = 0; g < 4; ++g) {
      f4 v; v[0] = acc[j][4 * g]; v[1] = acc[j][4 * g + 1]; v[2] = acc[j][4 * g + 2]; v[3] = acc[j][4 * g + 3];
      *(f4*)(sC + (j * 32 + c) * 132 + w * 32 + 8 * g + 4 * h) = v;
    }
  __syncthreads();
}
DI void zero_acc(f32x16 (&acc)[2][2]) {
#pragma unroll
  for (int i = 0; i < 2; ++i)
#pragma unroll
    for (int j = 0; j < 2; ++j)
#pragma unroll
      for (int r = 0; r < 16; ++r) acc[i][j][r] = 0.f;
}
template <class F> DI void epi(f32x16 (&acc)[2][2], F f) {
  const int lane = TID() & 63, w = TID() >> 6, wm = w >> 1, wn = w & 1, h = lane >> 5, c = lane & 31;
#pragma unroll
  for (int i = 0; i < 2; ++i)
#pragma unroll
    for (int j = 0; j < 2; ++j)
#pragma unroll
      for (int r = 0; r < 16; ++r) f(wm * 64 + i * 32 + crow(r, h), wn * 64 + j * 32 + c, acc[i][j][r]);
}

template <int W, class F> DI void stage_bf16(F f) {
  u16* sC = (u16*)smem;
  const int lane = TID() & 63, w = TID() >> 6, wm = w >> 1, wn = w & 1, h = lane >> 5, c = lane & 31;
#pragma unroll
  for (int i = 0; i < 2; ++i)
#pragma unroll
    for (int j = 0; j < (W == 128 ? 2 : 1); ++j)
#pragma unroll
      for (int r = 0; r < 16; ++r) sC[(wm * 64 + i * 32 + crow(r, h)) * (W + 8) + wn * (W / 2) + j * 32 + c] = f2bf(f(i, j, r));
  __syncthreads();
}
template <int W> DI void copy_out_bf16(u16* dst, size_t ld, int valid) {
  const u16* sC = (const u16*)smem;
  constexpr int CPR = W / 8;
  const int tid = TID();
#pragma unroll
  for (int q = 0; q < 128 * CPR / 256; ++q) {
    const int id = tid + 256 * q, row = id / CPR, cc = id % CPR;
    if (cc * 8 < valid) *(u32x4*)(dst + (size_t)row * ld + cc * 8) = *(const u32x4*)(sC + row * (W + 8) + cc * 8);
  }
}

template <class F> DI void stage_bf16_sw(F f) {
  u16* sC = (u16*)smem;
  const int lane = TID() & 63, w = TID() >> 6, wm = w >> 1, wn = w & 1, h = lane >> 5, c = lane & 31;
#pragma unroll
  for (int i = 0; i < 2; ++i)
#pragma unroll
    for (int j = 0; j < 2; ++j)
#pragma unroll
      for (int g = 0; g < 4; ++g) {
        u32x2 pk; pk[0] = pk2(f(i, j, 4 * g), f(i, j, 4 * g + 1)); pk[1] = pk2(f(i, j, 4 * g + 2), f(i, j, 4 * g + 3));
        *(u32x2*)(sC + (wn * 64 + j * 32 + c) * 136 + wm * 64 + i * 32 + 8 * g + 4 * h) = pk;
      }
  __syncthreads();
}
template <class F> DI void stage_bf16_sw64(F f) {
  u16* sC = (u16*)smem;
  const int lane = TID() & 63, w = TID() >> 6, wm = w >> 1, wn = w & 1, h = lane >> 5, c = lane & 31;
#pragma unroll
  for (int j = 0; j < 2; ++j)
#pragma unroll
    for (int g = 0; g < 4; ++g) {
      u32x2 pk; pk[0] = pk2(f(j, 4 * g), f(j, 4 * g + 1)); pk[1] = pk2(f(j, 4 * g + 2), f(j, 4 * g + 3));
      *(u32x2*)(sC + (wn * 64 + j * 32 + c) * 72 + wm * 32 + 8 * g + 4 * h) = pk;
    }
  __syncthreads();
}
DI void stage_f32(f32x16 (&acc)[2][2]) {
  float* sC = (float*)smem;
  const int lane = TID() & 63, w = TID() >> 6, wm = w >> 1, wn = w & 1, h = lane >> 5, c = lane & 31;
#pragma unroll
  for (int i = 0; i < 2; ++i)
#pragma unroll
    for (int j = 0; j < 2; ++j)
#pragma unroll
      for (int r = 0; r < 16; ++r) sC[(wm * 64 + i * 32 + crow(r, h)) * 132 + wn * 64 + j * 32 + c] = acc[i][j][r];
  __syncthreads();
}
DI int vblock() { const int nb = gridDim.x, b = BID(); return (nb & 7) ? b : (b & 7) * (nb >> 3) + (b >> 3); }
DI void decode_tile(int idx, int NT, int& mt, int& nt) { const int g = idx / (8 * NT); const int r = idx - g * 8 * NT; nt = r >> 3; mt = g * 8 + (r & 7); }


DI void group_sync(const Params& p, int& nbar) {
  if (!USE_GSYNC) return;
  __syncthreads();
  nbar += 1;
  if ((gridDim.x & 7) == 0 && TID() == 0) {
    u32* c = (u32*)(WSP(p) + WS_CTR) + 64 + 32 * (BID() & 7);
    const u32 target = (gridDim.x >> 3) * (u32)nbar;
    __hip_atomic_fetch_add(c, 1u, __ATOMIC_RELAXED, __HIP_MEMORY_SCOPE_AGENT);
    while (__hip_atomic_load(c, __ATOMIC_RELAXED, __HIP_MEMORY_SCOPE_AGENT) < target) __builtin_amdgcn_s_sleep(1);
  }
  __syncthreads();
}
#define TILE_LOOP(NT_TOTAL) \
  for (int rd_ = 0, idx = vblock(); rd_ < ((NT_TOTAL) + (int)gridDim.x - 1) / (int)gridDim.x; ++rd_, idx += gridDim.x)


#define XB_TMO      128
#define XB_XCNT(j)  (256  + 64 * (j))
#define XB_XSUB(j)  (1280 + 64 * (j))
#define XB_XGEN(j)  (2304 + 64 * (j))
#define XB_TOP      3328
#define XB_TOPGEN   3392
#define XCD_BAR_WORDS 3456
#define XB_SPIN_CAP (1u << 20)
#define LAS __attribute__((address_space(3)))
DI unsigned xb_ld(unsigned* p) { return __hip_atomic_load(p, __ATOMIC_RELAXED, __HIP_MEMORY_SCOPE_AGENT); }
DI unsigned xb_add(unsigned* p, unsigned v) { return __hip_atomic_fetch_add(p, v, __ATOMIC_RELAXED, __HIP_MEMORY_SCOPE_AGENT); }
DI unsigned xb_xcc_id() { return (unsigned)__builtin_amdgcn_s_getreg((3 << 11) | 20) & 0xFu; }
#define XB_SPIN(cond, bar) do { unsigned _sp = 0; while (cond) { __builtin_amdgcn_s_sleep(1); \
    if ((++_sp & 255u) == 0u) { if (xb_ld(&(bar)[XB_TMO])) break; if (_sp > XB_SPIN_CAP) { atomicAdd(&(bar)[XB_TMO], 1u); break; } } } } while (0)
__shared__ uint4 xb_words;
DI void xcd_barrier_complete(unsigned* bar, unsigned x, unsigned& nloc, unsigned& nx) {
  const unsigned G = gridDim.x;
  unsigned sum, cnt, mine, sp = 0u;
  for (;;) {
    sum = 0u; cnt = 0u; mine = 0u;
#pragma unroll
    for (unsigned j = 0; j < 16; ++j) { const unsigned c = xb_ld(&bar[XB_XCNT(j)]); sum += c; cnt += (c > 0u) ? 1u : 0u; mine = (j == x) ? c : mine; }
    if (sum == G) break;
    __builtin_amdgcn_s_sleep(1);
    if ((++sp & 255u) == 0u) { if (xb_ld(&bar[XB_TMO])) break; if (sp > XB_SPIN_CAP) { atomicAdd(&bar[XB_TMO], 1u); break; } }
  }
  nloc = mine > 0u ? mine : 1u; nx = cnt > 0u ? cnt : 1u;
}
DI void gsync(const Params& p) {
  asm volatile("s_waitcnt vmcnt(0)" ::: "memory");
  __syncthreads();
  if (threadIdx.x == 0) {
    unsigned* bar = (unsigned*)(WSP(p) + WS_BAR);
    volatile LAS unsigned* st = (volatile LAS unsigned*)&xb_words;
    const unsigned x = xb_xcc_id();
    __builtin_amdgcn_s_waitcnt(0);
    unsigned nloc = st[0], nx = st[1];
    if (nloc == 0u) { xcd_barrier_complete(bar, x, nloc, nx); st[0] = nloc; st[1] = nx; }
    const unsigned old = xb_add(&bar[XB_XSUB(x)], 1u);
    const unsigned gen = old / nloc;
    if (old + 1u == (gen + 1u) * nloc) {
      __builtin_amdgcn_fence(__ATOMIC_RELEASE, "agent");
      asm volatile("s_waitcnt vmcnt(0)" ::: "memory");
      const unsigned og = xb_add(&bar[XB_TOP], 1u);
      const unsigned tg = og / nx;
      if (og + 1u == (tg + 1u) * nx) xb_add(&bar[XB_TOPGEN], 1u);
      else XB_SPIN(xb_ld(&bar[XB_TOPGEN]) == tg, bar);
      __builtin_amdgcn_fence(__ATOMIC_ACQUIRE, "agent");
      xb_add(&bar[XB_XGEN(x)], 1u);
      asm volatile("s_waitcnt vmcnt(0)" ::: "memory");
    } else {
      XB_SPIN(xb_ld(&bar[XB_XGEN(x)]) == gen, bar);
      __builtin_amdgcn_fence(__ATOMIC_ACQUIRE, "agent");
      asm volatile("s_waitcnt vmcnt(0)" ::: "memory");
    }
  }
  __syncthreads();
}

DI void conv_matrix(const float* src, int K, int ldn, int N, u16* dst, const float* scale, int mode, int off, int rot) {
  float* sm = (float*)smem;
  const int tid = TID(), nb = gridDim.x;
  const int nkt = K >> 6, nnt = (N + 63) >> 6;
  int b0 = BID() - rot; if (b0 < 0) b0 += nb;
  for (int it = b0; it < nkt * nnt; it += nb) {
    const int kt = it % nkt, nt = it / nkt, k0 = kt * 64, n0 = nt * 64;
    __syncthreads();
    const int r = tid >> 4, c4 = (tid & 15) * 4;
#pragma unroll
    for (int p = 0; p < 4; ++p) {
      const int k = r + 16 * p;
      f4 v = {0.f, 0.f, 0.f, 0.f};
      if (n0 + c4 < N) v = *(const f4*)(src + (size_t)(k0 + k) * ldn + n0 + c4);
      if (scale) { const float s = scale[k0 + k]; v *= s; }
      sm[k * 65 + c4 + 0] = v[0]; sm[k * 65 + c4 + 1] = v[1]; sm[k * 65 + c4 + 2] = v[2]; sm[k * 65 + c4 + 3] = v[3];
    }
    __syncthreads();
    const int n = tid & 63, kc = tid >> 6;
    if (n0 + n < N) {
      const int ng = n0 + n;
      const int row = (mode & 4) ? ((ng >> 4) * 32 + (ng & 15) + off) : (mode & 1) ? ((ng >> 5) * 64 + (ng & 31) + off) : ng;
#pragma unroll
      for (int q = 0; q < 2; ++q) {
        const int c = kc + 4 * q;
        const float* s = sm + (8 * c) * 65 + n;
        u32x4 o;
        o[0] = pk2(s[0], s[65]); o[1] = pk2(s[2 * 65], s[3 * 65]); o[2] = pk2(s[4 * 65], s[5 * 65]); o[3] = pk2(s[6 * 65], s[7 * 65]);
        if (mode & 2) *(u32x4*)(dst + ((size_t)(row >> 5) * (K >> 4) + ((k0 + 8 * c) >> 4)) * 512 + (((k0 + 8 * c) >> 3) & 1) * 256 + (row & 31) * 8) = o;
        else *(u32x4*)(dst + (size_t)row * K + k0 + 8 * c) = o;
      }
    }
  }
}

DI void norm_phase(const Params& p, int l, int which) {
  const float* X = OUTP(p);
  u16* H = (u16*)(WSP(p) + WS_H);
  const float* nw = INP(p, which ? I_N2 : I_N1) + l * 1024;
  const float* MOD = (const float*)(WSP(p) + WS_MOD) + (size_t)l * 5 * 6144;
  const int lane = TID() & 63, gw = BID() * 4 + (TID() >> 6), nw_ = gridDim.x * 4;
  for (int t = gw; t < T; t += nw_) {
    const int cb = t < TC ? 0 : 1 + ((t - TC) >> 12);
    const float* sh = MOD + cb * 6144 + (which ? 3 : 0) * 1024;
    const float* sc = sh + 1024;
    const f4* xr = (const f4*)(X + (size_t)t * 1024) + lane;
    f4 v[4]; float s = 0.f;
#pragma unroll
    for (int j = 0; j < 4; ++j) { v[j] = xr[64 * j]; s += v[j][0] * v[j][0] + v[j][1] * v[j][1] + v[j][2] * v[j][2] + v[j][3] * v[j][3]; }
    const float rstd = rsqrtf(wave_sum(s) * (1.f / 1024.f) + EPS);
#pragma unroll
    for (int j = 0; j < 4; ++j) {
      const int c = 4 * lane + 256 * j;
      const f4 wv = *(const f4*)(nw + c), scv = *(const f4*)(sc + c), shv = *(const f4*)(sh + c);
      float o[4];
#pragma unroll
      for (int e = 0; e < 4; ++e) o[e] = v[j][e] * rstd * wv[e] * (1.f + scv[e]) + shv[e];
      u32x2 pk; pk[0] = pk2(o[0], o[1]); pk[1] = pk2(o[2], o[3]);
      *(u32x2*)(H + (size_t)t * 1024 + c) = pk;
    }
  }
}

DI void pre_phase(const Params& p) {
  const int tid = TID(), nb = gridDim.x;
  if (BID() == 0) { for (int i = tid; i < 1024; i += 256) ((u32*)(WSP(p) + WS_CTR))[i] = 0u; }
  {
    f4* X4 = (f4*)OUTP(p);
    const f4* xp = (const f4*)INP(p, I_XP); const f4* xs = (const f4*)INP(p, I_XS);
    const int n4 = T * 256, nc4 = TC * 256;
    for (int i = BID() * 256 + tid; i < n4; i += nb * 256) X4[i] = (i < nc4) ? xp[i] : xs[i - nc4];
  }
  float* sm = (float*)smem;
  float* MOD = (float*)(WSP(p) + WS_MOD);
  __syncthreads();
  for (int i = tid; i < 5 * 1024; i += 256) {
    const int cb = i >> 10, k = i & 1023;
    const float cv = cb == 0 ? INP(p, I_CCTX)[k] : INP(p, I_C)[(cb - 1) * 1024 + k];
    sm[i] = silu_f(cv);
  }
  __syncthreads();
  float* red = sm + 5 * 1024;
  for (int it = BID(); it < NLAYER * 48; it += nb) {
    const int l = it / 48, n0 = (it % 48) * 128;
    const int c4 = (tid & 31) * 4, kg = tid >> 5;
    float a[5][4];
#pragma unroll
    for (int cb = 0; cb < 5; ++cb)
#pragma unroll
      for (int e = 0; e < 4; ++e) a[cb][e] = 0.f;
    const float* wsrc = INP(p, I_WADA) + (size_t)l * 1024 * 6144 + n0 + c4;
    for (int k = kg * 128; k < kg * 128 + 128; ++k) {
      const f4 wv = *(const f4*)(wsrc + (size_t)k * 6144);
#pragma unroll
      for (int cb = 0; cb < 5; ++cb) {
        const float s = sm[cb * 1024 + k];
#pragma unroll
        for (int e = 0; e < 4; ++e) a[cb][e] += s * wv[e];
      }
    }
    __syncthreads();
#pragma unroll
    for (int cb = 0; cb < 5; ++cb)
#pragma unroll
      for (int e = 0; e < 4; ++e) red[(kg * 5 + cb) * 128 + c4 + e] = a[cb][e];
    __syncthreads();
    for (int o = tid; o < 5 * 128; o += 256) {
      const int cb = o >> 7, n = o & 127;
      float s = INP(p, I_BADA)[l * 6144 + n0 + n];
#pragma unroll
      for (int g = 0; g < 8; ++g) s += red[(g * 5 + cb) * 128 + n];
      MOD[((size_t)l * 5 + cb) * 6144 + n0 + n] = s;
    }
  }
}

DI void l1_phase(const Params& p, int l) {
  u16* W = (u16*)(WSP(p) + WS_W);
  conv_matrix(INP(p, I_WIN) + (size_t)l * 1024 * INC, 1024, INC, NPROJ, W + W_IN, nullptr, 2, 0, 0);
  conv_matrix(INP(p, I_WIN) + (size_t)l * 1024 * INC + NPROJ, 1024, INC, 3072, W + W_GATE, nullptr, 2, 0, 300);
  conv_matrix(INP(p, I_F1) + (size_t)l * 1024 * FF, 1024, FF, FF, W + W_F13, nullptr, 6, 0, 64);
  conv_matrix(INP(p, I_F3) + (size_t)l * 1024 * FF, 1024, FF, FF, W + W_F13, nullptr, 6, 16, 128);
  conv_matrix(INP(p, I_F2) + (size_t)l * FF * 1024, FF, 1024, 1024, W + W_F2, nullptr, 2, 0, 192);
  conv_matrix(INP(p, I_WAO) + (size_t)l * 512 * 1024, 512, 1024, 1024, W + W_A, nullptr, 0, 0, 32);
  conv_matrix(INP(p, I_WBO) + (size_t)l * 1024 * 1024, 1024, 1024, 1024, W + W_B, INP(p, I_SNW) + l * 1024, 0, 0, 96);
  conv_matrix(INP(p, I_WUQ) + (size_t)l * 256 * 768, 256, 768, 768, W + W_UQ, INP(p, I_QNW) + l * 256, 0, 0, 160);
  conv_matrix(INP(p, I_WUKV) + (size_t)l * 256 * 1024, 256, 1024, 1024, W + W_UKV, nullptr, 0, 0, 224);
  conv_matrix(INP(p, I_WCO) + (size_t)l * 512 * 1024, 512, 1024, 1024, W + W_C, nullptr, 0, 0, 16);
  conv_matrix(INP(p, I_WO) + (size_t)l * 1024 * 1024, 1024, 1024, 1024, W + W_O, nullptr, 2, 0, 80);
  norm_phase(p, l, 0);
}

DI void l2_phase(const Params& p, int l, int& nbar) {
  const u16* H = (const u16*)(WSP(p) + WS_H);
  const u16* W = (const u16*)(WSP(p) + WS_W) + W_IN;
  u16* ACT = (u16*)(WSP(p) + WS_ACT);
  float* DT = (float*)(WSP(p) + WS_DT);
  constexpr int NT = 37, MT = 80;
  TILE_LOOP(MT * NT) {
    group_sync(p, nbar);
    if (idx >= MT * NT) continue;
    int mt, nt; decode_tile(idx, NT, mt, nt);
    f32x16 acc[8];
#pragma unroll
    for (int j = 0; j < 8; ++j)
#pragma unroll
      for (int r = 0; r < 16; ++r) acc[j][r] = 0.f;
    gemm_tile_wf8(W, 1024, nt * 128, H + (size_t)mt * 256 * 1024, 1024, acc);
    const int m0 = mt * 256, n0 = nt * 128;
    if (nt == 32 || (nt == 36 && mt < 16)) {
      const int lane = TID() & 63, w = TID() >> 6, h = lane >> 5, c = lane & 31;
#pragma unroll
      for (int j = 0; j < 8; ++j)
#pragma unroll
        for (int r = 0; r < 16; ++r) {
          const int t = m0 + j * 32 + c, cc = n0 + w * 32 + crow(r, h);
          const float v = acc[j][r];
          if (cc >= C_DT && cc < C_DT + 16) DT[t * 16 + cc - C_DT] = v;
          if (cc >= C_KR && cc < NPROJ && t < TC) OUTP(p)[O_KR + ((size_t)((t >> 8) * 4 + l) * 256 + (t & 255)) * 32 + (cc - C_KR)] = v;
        }
    }
    stage_bf16_w8([&](int j, int r) { return acc[j][r]; });
    copy_out_bf16_256x128(ACT + (size_t)m0 * LDA + n0, LDA, NPROJ - n0);
  }
}

DI void unpack8(const u32x4 v, float (&f)[8]) {
#pragma unroll
  for (int i = 0; i < 4; ++i) { f[2 * i] = bflo(v[i]); f[2 * i + 1] = bfhi(v[i]); }
}
DI u32x4 pack8(const float (&f)[8]) { u32x4 o; o[0] = pk2(f[0], f[1]); o[1] = pk2(f[2], f[3]); o[2] = pk2(f[4], f[5]); o[3] = pk2(f[6], f[7]); return o; }

DI void l3_phase(const Params& p, int l) {
  const u16* ACT = (const u16*)(WSP(p) + WS_ACT);
  const int tid = TID(), nb = gridDim.x;
  {
    u16* YA = (u16*)(WSP(p) + WS_YA);
    const float* cw = INP(p, I_ACW) + l * 3 * 512;
    for (int it = BID() * 256 + tid; it < T * 64; it += nb * 256) {
      const int t = it >> 6, c8 = (it & 63) * 8;
      const int pos = t < TC ? (t & 255) : ((t - TC) & 4095);
      const int L = t < TC ? 256 : 4096;
      const u16* row = ACT + (size_t)t * LDA;
      float u0[8], u1[8], u2[8], ab[8], a1[8], a2[8];
      unpack8(*(const u32x4*)(row + C_AX + c8), a1); unpack8(*(const u32x4*)(row + C_AC + c8), a2);
#pragma unroll
      for (int e = 0; e < 8; ++e) u1[e] = a1[e] * a2[e];
      if (pos > 0) {
        unpack8(*(const u32x4*)(row - LDA + C_AX + c8), a1); unpack8(*(const u32x4*)(row - LDA + C_AC + c8), a2);
#pragma unroll
        for (int e = 0; e < 8; ++e) u0[e] = a1[e] * a2[e];
      } else {
#pragma unroll
        for (int e = 0; e < 8; ++e) u0[e] = 0.f;
      }
      if (pos < L - 1) {
        unpack8(*(const u32x4*)(row + LDA + C_AX + c8), a1); unpack8(*(const u32x4*)(row + LDA + C_AC + c8), a2);
#pragma unroll
        for (int e = 0; e < 8; ++e) u2[e] = a1[e] * a2[e];
      } else {
#pragma unroll
        for (int e = 0; e < 8; ++e) u2[e] = 0.f;
      }
      unpack8(*(const u32x4*)(row + C_AB + c8), ab);
      float o[8];
#pragma unroll
      for (int e = 0; e < 8; ++e) o[e] = ab[e] * (cw[c8 + e] * u0[e] + cw[512 + c8 + e] * u1[e] + cw[1024 + c8 + e] * u2[e]);
      *(u32x4*)(YA + (size_t)t * 512 + c8) = pack8(o);
    }
  }
  {
    u16* XT = (u16*)(WSP(p) + WS_XT); u16* BCP = (u16*)(WSP(p) + WS_BCP); u16* BT = (u16*)(WSP(p) + WS_BT);
    const float* cw = INP(p, I_SCW) + l * 3 * 1536;
    const float* cbias = INP(p, I_SCB) + l * 1536;
    u16* sr = (u16*)smem;
    for (int it = BID(); it < 160 * 24; it += nb) {
      const int chunk = it / 24, cbk = it % 24, ch0 = cbk * 64, t0 = chunk * 128;
      const bool first = chunk < 32 ? ((chunk & 1) == 0) : (((chunk - 32) & 31) == 0);
      const bool last = chunk < 32 ? ((chunk & 1) == 1) : (((chunk - 32) & 31) == 31);
      __syncthreads();
      for (int id = tid; id < 130 * 8; id += 256) {
        const int r = id >> 3, c8 = (id & 7) * 8;
        u32x4 v = {0u, 0u, 0u, 0u};
        const bool ok = !((r == 0 && first) || (r == 129 && last));
        if (ok) v = *(const u32x4*)(ACT + (size_t)(t0 - 1 + r) * LDA + C_XBC + ch0 + c8);
        *(u32x4*)(sr + r * 72 + c8) = v;
      }
      __syncthreads();
      if (cbk >= 16) {
        const int c8 = (tid & 7) * 8;
        float w0[8], w1[8], w2[8], bb[8];
#pragma unroll
        for (int e = 0; e < 8; ++e) { w0[e] = cw[ch0 + c8 + e]; w1[e] = cw[1536 + ch0 + c8 + e]; w2[e] = cw[3072 + ch0 + c8 + e]; bb[e] = cbias[ch0 + c8 + e]; }
#pragma unroll
        for (int q = 0; q < 4; ++q) {
          const int r = (tid >> 3) + 32 * q;
          float x0[8], x1[8], x2[8], o[8];
          unpack8(*(const u32x4*)(sr + r * 72 + c8), x0); unpack8(*(const u32x4*)(sr + (r + 1) * 72 + c8), x1); unpack8(*(const u32x4*)(sr + (r + 2) * 72 + c8), x2);
#pragma unroll
          for (int e = 0; e < 8; ++e) o[e] = silu_f(w0[e] * x0[e] + w1[e] * x1[e] + w2[e] * x2[e] + bb[e]);
          *(u32x4*)(BCP + (size_t)(t0 + r) * 512 + (ch0 - 1024) + c8) = pack8(o);
        }
      }
      if (cbk < 20) {
        const int ch = tid & 63, jg0 = tid >> 6;
        const float w0 = cw[ch0 + ch], w1 = cw[1536 + ch0 + ch], w2 = cw[3072 + ch0 + ch], bb = cbias[ch0 + ch];
        u16* dst = cbk < 16 ? XT + ((size_t)chunk * 1024 + ch0 + ch) * 128 : BT + ((size_t)chunk * 256 + (ch0 - 1024) + ch) * 128;
#pragma unroll
        for (int q = 0; q < 4; ++q) {
          const int g = jg0 + 4 * q;
          float xv[10], o[8];
#pragma unroll
          for (int e = 0; e < 10; ++e) xv[e] = bf2f(sr[(8 * g + e) * 72 + ch]);
#pragma unroll
          for (int e = 0; e < 8; ++e) o[e] = silu_f(w0 * xv[e] + w1 * xv[e + 1] + w2 * xv[e + 2] + bb);
          *(u32x4*)(dst + 8 * g) = pack8(o);
        }
      }
    }
  }
  {
    u16* CKVA = (u16*)(WSP(p) + WS_CKVA); u16* KRA = (u16*)(WSP(p) + WS_KR);
    float* RQ = (float*)(WSP(p) + WS_RQ);
    const float* kvw = INP(p, I_KVNW) + l * 256;
    const int lane = tid & 63, gw = BID() * 4 + (tid >> 6), nwv = nb * 4;
    for (int it = gw; it < T + 2048; it += nwv) {
      if (it < T) {
        const int t = it;
        const u16* row = ACT + (size_t)t * LDA;
        const u32x2 kv = *(const u32x2*)(row + C_CKV + 4 * lane);
        const u32x2 qv = *(const u32x2*)(row + C_CQ + 4 * lane);
        float k4[4] = {bflo(kv[0]), bfhi(kv[0]), bflo(kv[1]), bfhi(kv[1])};
        float q4[4] = {bflo(qv[0]), bfhi(qv[0]), bflo(qv[1]), bfhi(qv[1])};
        const float ssk = wave_sum(k4[0] * k4[0] + k4[1] * k4[1] + k4[2] * k4[2] + k4[3] * k4[3]);
        const float ssq = wave_sum(q4[0] * q4[0] + q4[1] * q4[1] + q4[2] * q4[2] + q4[3] * q4[3]);
        const float rk = rsqrtf(ssk * (1.f / 256.f) + EPS);
        if (lane == 0) RQ[t] = rsqrtf(ssq * (1.f / 256.f) + EPS);
        const f4 wv = *(const f4*)(kvw + 4 * lane);
        f4 o; o[0] = k4[0] * rk * wv[0]; o[1] = k4[1] * rk * wv[1]; o[2] = k4[2] * rk * wv[2]; o[3] = k4[3] * rk * wv[3];
        int krow, pos;
        if (t < TC) { krow = KROW_CTX + t; pos = t & 255; *(f4*)(OUTP(p) + O_CKV + ((size_t)((t >> 8) * 4 + l) * 256 + pos) * 256 + 4 * lane) = o; }
        else { const int b = (t - TC) >> 12; pos = (t - TC) & 4095; krow = b * LKL + 512 + pos; }
        u32x2 pk; pk[0] = pk2(o[0], o[1]); pk[1] = pk2(o[2], o[3]);
        *(u32x2*)(CKVA + (size_t)krow * 256 + 4 * lane) = pk;
        if (lane < 16) {
          float x1 = bf2f(row[C_KR + lane]), x2 = bf2f(row[C_KR + 16 + lane]);
          if (t >= TC) {
            const float pp = (lane < 8) ? (float)(pos >> 6) : (float)(pos & 63);
            const float inv = exp2f(-(float)(lane & 7) * (13.287712379549449f / 8.f));
            const float ang = pp * inv;
            const float cs = cosf(ang), sn = sinf(ang);
            const float y1 = x1 * cs - x2 * sn, y2 = x1 * sn + x2 * cs;
            x1 = y1; x2 = y2;
          }
          KRA[(size_t)krow * 32 + lane] = f2bf(x1); KRA[(size_t)krow * 32 + 16 + lane] = f2bf(x2);
        }
      } else {
        const int j = it - T, b = j >> 9, r = j & 511;
        const int krow = b * LKL + r;
        const f4 v = *(const f4*)(INP(p, I_CCKV) + ((size_t)(b * 4 + l) * 512 + r) * 256 + 4 * lane);
        u32x2 pk; pk[0] = pk2(v[0], v[1]); pk[1] = pk2(v[2], v[3]);
        *(u32x2*)(CKVA + (size_t)krow * 256 + 4 * lane) = pk;
        if (lane < 32) KRA[(size_t)krow * 32 + lane] = f2bf(INP(p, I_CKR)[((size_t)(b * 4 + l) * 512 + r) * 32 + lane]);
      }
    }
  }
}

DI void l3d_phase(const Params& p, int l) {
  const float* DT = (const float*)(WSP(p) + WS_DT);
  float* CUMS = (float*)(WSP(p) + WS_CUMS);
  const int tid = TID(), lane = tid & 63, gw = BID() * 4 + (tid >> 6), nwv = gridDim.x * 4;
  for (int it = gw; it < 160 * 32; it += nwv) {
    const int chunk = it >> 5, dir = (it >> 4) & 1, head = it & 15, t0 = chunk * 128;
    const float a = -__expf(INP(p, I_ALOG)[(l * 2 + dir) * 16 + head]);
    const float dtb = INP(p, I_DTB)[(l * 2 + dir) * 16 + head];
    const int k0 = 2 * lane, k1 = 2 * lane + 1;
    const int tk0 = dir ? 127 - k0 : k0, tk1 = dir ? 127 - k1 : k1;
    const float x0 = DT[(t0 + tk0) * 16 + head] + dtb, x1 = DT[(t0 + tk1) * 16 + head] + dtb;
    const float d0 = x0 > 20.f ? x0 : log1pf(__expf(x0)), d1 = x1 > 20.f ? x1 : log1pf(__expf(x1));
    const float v0 = d0 * a, v1 = d1 * a;
    float s = v0 + v1;
#pragma unroll
    for (int o = 1; o < 64; o <<= 1) { const float n = __shfl_up(s, o); if (lane >= o) s += n; }
    const float total = __shfl(s, 63);
    const float c1 = s, c0 = s - v1;
    float* cs = CUMS + (size_t)it * 768;
    const float cref = __shfl(c1, (lane & ~7) | 7);
    cs[tk0] = c0; cs[tk1] = c1; cs[128 + tk0] = __expf(cref - c0) * d0; cs[128 + tk1] = __expf(cref - c1) * d1;
    cs[640 + tk0] = d0; cs[640 + tk1] = d1;
    {
      const float cfirst = __shfl(c0, lane & ~7);
      if ((lane & 7) == 7) { cs[520 + (tk1 >> 4)] = c1; cs[528 + (tk1 >> 4)] = cfirst - c1; }
    }
    cs[256 + tk0] = __expf(total - c0) * d0; cs[256 + tk1] = __expf(total - c1) * d1;
    cs[384 + tk0] = __expf(c0); cs[384 + tk1] = __expf(c1);
    if (lane == 0) cs[512] = __expf(total);
  }
}

DI void l4_phase(const Params& p, int l, int& nbar) {
  constexpr int NQ = 160 * 6, NKV = 176 * 8, NCB = 320;
  TILE_LOOP(NQ + NKV + NCB) {
    group_sync(p, nbar);
    if (idx >= NQ + NKV + NCB) continue;
    const u16* W = (const u16*)(WSP(p) + WS_W);
    const u16* ACT = (const u16*)(WSP(p) + WS_ACT);
    f32x16 acc[2][2]; zero_acc(acc);
    if (idx < NQ) {
      int mt, nt; decode_tile(idx, 6, mt, nt);
      gemm_tile(W + W_UQ + (size_t)nt * 128 * 256, 256, ACT + (size_t)mt * 128 * LDA + C_CQ, LDA, 256, acc);
      const float* RQ = (const float*)(WSP(p) + WS_RQ);
      u16* Q = (u16*)(WSP(p) + WS_Q);
      const int m0 = mt * 128, n0 = nt * 128;
      {
        const int lane = TID() & 63, w = TID() >> 6, wn = w & 1, c = lane & 31;
        const float rq0 = RQ[m0 + wn * 64 + c], rq1 = RQ[m0 + wn * 64 + 32 + c];
        stage_bf16_sw([&](int i, int j, int r) { return acc[i][j][r] * (j ? rq1 : rq0); });
        copy_out_bf16<128>(Q + (size_t)m0 * 768 + n0, 768, 128);
      }
    } else if (idx < NQ + NKV) {
      int mt, nt; decode_tile(idx - NQ, 8, mt, nt);
      gemm_tile((const u16*)(WSP(p) + WS_CKVA) + (size_t)mt * 128 * 256, 256, W + W_UKV + (size_t)nt * 128 * 256, 256, 256, acc);
      u16* KN = (u16*)(WSP(p) + WS_KN); u16* VT = (u16*)(WSP(p) + WS_VT);
      const int lane = TID() & 63, w = TID() >> 6, wm = w >> 1, wn = w & 1, h = lane >> 5, c = lane & 31;
      const int kr0 = mt * 128;
      size_t vbase; int Lk, key0;
      if (kr0 < KROW_CTX) { const int b = kr0 / LKL; key0 = kr0 - b * LKL; Lk = LKL; vbase = (size_t)b * 512 * LKL; }
      else { const int s = (kr0 - KROW_CTX) >> 8; key0 = (kr0 - KROW_CTX) & 255; Lk = 256; vbase = (size_t)4 * 512 * LKL + (size_t)s * 512 * 256; }
#pragma unroll
      for (int i = 0; i < 2; ++i)
#pragma unroll
        for (int j = 0; j < 2; ++j) {
          const int d = j * 32 + c;
          if (wn == 0) {
#pragma unroll
            for (int r = 0; r < 16; ++r) KN[(size_t)(kr0 + wm * 64 + i * 32 + crow(r, h)) * 512 + nt * 64 + d] = f2bf(acc[i][j][r]);
          } else {
#pragma unroll
            for (int g = 0; g < 4; ++g) {
              const int key = key0 + wm * 64 + i * 32 + 8 * g + 4 * h;
              u32x2 pk; pk[0] = pk2(acc[i][j][4 * g], acc[i][j][4 * g + 1]); pk[1] = pk2(acc[i][j][4 * g + 2], acc[i][j][4 * g + 3]);
              *(u32x2*)(VT + vbase + (size_t)(nt * 64 + d) * Lk + key) = pk;
            }
          }
        }
    } else {
      const int ci = idx - NQ - NKV, chunk = ci >> 1, g = ci & 1;
      const u16* BCP = (const u16*)(WSP(p) + WS_BCP) + (size_t)chunk * 128 * 512;
      gemm_tile(BCP + 256 + g * 128, 512, BCP + g * 128, 512, 128, acc);
      u16* CB = (u16*)(WSP(p) + WS_CB) + (size_t)ci * 128 * 128;
      epi(acc, [&](int m, int n, float v) { CB[m * 128 + n] = f2bf(v); });
    }
  }
}

DI void ssd_unit(const Params& p, int l, int unit) {
  const int tid = TID(), lane = tid & 63, w = __builtin_amdgcn_readfirstlane(tid >> 6), h = lane >> 5, c = lane & 31;
  int dir, head, nc, chunk0, sidx; bool lat;
  if (unit < 128) { lat = true; sidx = unit >> 5; dir = (unit >> 4) & 1; head = unit & 15; nc = 32; chunk0 = 32 + sidx * 32; }
  else { const int u = unit - 128; lat = false; sidx = u >> 5; dir = (u >> 4) & 1; head = u & 15; nc = 2; chunk0 = sidx * 2; }
  const int g = head >> 3;
  const float Dk = INP(p, I_SD)[(l * 2 + dir) * 16 + head];
  u16* sXT = (u16*)smem; u16* sXS = sXT + 64 * 136; u16* sHS = sXS + 64 * 136;
  float* cum = (float*)(sHS + 64 * 136); float* dtv = cum + 128; float* ecum = dtv + 128; float* dtr = ecum + 128;
  const u16* XT = (const u16*)(WSP(p) + WS_XT); const u16* BCP = (const u16*)(WSP(p) + WS_BCP); const u16* BT = (const u16*)(WSP(p) + WS_BT);
  const u16* CB = (const u16*)(WSP(p) + WS_CB); const float* CUMS = (const float*)(WSP(p) + WS_CUMS);
  u16* Y = (u16*)(WSP(p) + WS_ACT) + (dir ? C_YB : C_YF);
  f32x16 S[2];
  if (lat) {
    const float* st = INP(p, dir ? I_STB : I_STF) + ((size_t)((sidx * 4 + l) * 16 + head) * 64) * 128;
#pragma unroll
    for (int mt = 0; mt < 2; ++mt)
#pragma unroll
      for (int r = 0; r < 16; ++r) S[mt][r] = st[(size_t)(32 * mt + crow(r, h)) * 128 + 32 * w + c];
  } else {
#pragma unroll
    for (int mt = 0; mt < 2; ++mt)
#pragma unroll
      for (int r = 0; r < 16; ++r) S[mt][r] = 0.f;
  }
  __syncthreads();
#pragma unroll
  for (int mt = 0; mt < 2; ++mt)
#pragma unroll
    for (int r = 0; r < 16; ++r) sHS[(32 * mt + crow(r, h)) * 136 + 32 * w + c] = f2bf(S[mt][r]);
  const int i = 32 * w + c;
  const int ks_lo = dir ? 2 * w : 0, ks_hi = dir ? 8 : 2 * w + 2;
  const int pr0 = tid >> 4, j0 = (tid & 15) * 8;

  for (int step = 0; step < nc; ++step) {
    const int chunk = chunk0 + (dir ? nc - 1 - step : step);
    const int t0 = chunk * 128;
    const float* cs = CUMS + ((size_t)(chunk * 2 + dir) * 16 + head) * 768;
    u32x4 xr[4];
    const u16* xsrc = XT + ((size_t)chunk * 1024 + head * 64) * 128;
#pragma unroll
    for (int q = 0; q < 4; ++q) xr[q] = *(const u32x4*)(xsrc + (size_t)(pr0 + 16 * q) * 128 + j0);
    const f4 e1lo = *(const f4*)(cs + 256 + j0), e1hi = *(const f4*)(cs + 256 + j0 + 4);
    float t_cum = 0.f, t_dt = 0.f, t_ec = 0.f;
    float t_dr = 0.f;
    if (tid < 128) { t_cum = cs[tid]; t_dt = cs[128 + tid]; t_ec = cs[384 + tid]; t_dr = cs[640 + tid]; }
    const float dec = cs[512];
    float cref8[8], span8[8];
#pragma unroll
    for (int ks = 0; ks < 8; ++ks) { cref8[ks] = cs[520 + ks]; span8[ks] = cs[528 + ks]; }
    const u16* crowp = BCP + (size_t)(t0 + i) * 512 + 256 + g * 128 + 8 * h;
    const u16* cbrow = CB + ((size_t)(chunk * 2 + g) * 128 + i) * 128 + 8 * h;
    const u16* btrow = BT + ((size_t)chunk * 256 + g * 128 + 32 * w + c) * 128 + 8 * h;
    bf16x8 cf[8], btf[8]; u32x4 cbf[8];
#pragma unroll
    for (int ks = 0; ks < 8; ++ks) cf[ks] = *(const bf16x8*)(crowp + ks * 16);
#pragma unroll
    for (int ks = 0; ks < 8; ++ks) { u32x4 z = {0u, 0u, 0u, 0u}; cbf[ks] = (ks >= ks_lo && ks < ks_hi) ? *(const u32x4*)(cbrow + ks * 16) : z; }
#pragma unroll
    for (int ks = 0; ks < 8; ++ks) btf[ks] = *(const bf16x8*)(btrow + ks * 16);
    __builtin_amdgcn_sched_barrier(0);
    if (tid < 128) { cum[tid] = t_cum; dtv[tid] = t_dt; ecum[tid] = t_ec; dtr[tid] = t_dr; }
    {
      const float e1v[8] = {e1lo[0], e1lo[1], e1lo[2], e1lo[3], e1hi[0], e1hi[1], e1hi[2], e1hi[3]};
#pragma unroll
      for (int q = 0; q < 4; ++q) {
        const int pr = pr0 + 16 * q;
        *(u32x4*)(sXT + pr * 136 + j0) = xr[q];
        float f[8]; unpack8(xr[q], f);
#pragma unroll
        for (int e = 0; e < 8; ++e) f[e] *= e1v[e];
        *(u32x4*)(sXS + pr * 136 + j0) = pack8(f);
      }
    }
    __syncthreads();
    f32x16 Y1[2];
#pragma unroll
    for (int nt = 0; nt < 2; ++nt)
#pragma unroll
      for (int r = 0; r < 16; ++r) Y1[nt][r] = 0.f;
#pragma unroll
    for (int ks = 0; ks < 8; ++ks) {
#pragma unroll
      for (int nt = 0; nt < 2; ++nt) {
        const bf16x8 bfv = *(const bf16x8*)(sHS + (32 * nt + c) * 136 + ks * 16 + 8 * h);
        Y1[nt] = MFMA(cf[ks], bfv, Y1[nt]);
      }
    }
#pragma unroll
    for (int nt = 0; nt < 2; ++nt)
#pragma unroll
      for (int r = 0; r < 16; ++r) Y1[nt][r] *= ecum[32 * w + crow(r, h)];
    const float ci_ = cum[i];
#pragma unroll
    for (int ks = 0; ks < 8; ++ks) {
      if (ks >= ks_lo && ks < ks_hi) {
        float f[8]; unpack8(cbf[ks], f);
        if (span8[ks] <= 40.f) {
          const float rowf = __expf(fminf(ci_ - cref8[ks], 80.f));
#pragma unroll
          for (int e = 0; e < 8; ++e) {
            const int j = ks * 16 + 8 * h + e;
            const bool ok = dir ? (j >= i) : (j <= i);
            f[e] = ok ? f[e] * rowf * dtv[j] : 0.f;
          }
        } else {
#pragma unroll
          for (int e = 0; e < 8; ++e) {
            const int j = ks * 16 + 8 * h + e;
            const bool ok = dir ? (j >= i) : (j <= i);
            f[e] = ok ? f[e] * __expf(fminf(ci_ - cum[j], 0.f)) * dtr[j] : 0.f;
          }
        }
        const bf16x8 af = __builtin_bit_cast(bf16x8, pack8(f));
#pragma unroll
        for (int nt = 0; nt < 2; ++nt) {
          const bf16x8 bfv = *(const bf16x8*)(sXT + (32 * nt + c) * 136 + ks * 16 + 8 * h);
          Y1[nt] = MFMA(af, bfv, Y1[nt]);
        }
      }
    }
#pragma unroll
    for (int nt = 0; nt < 2; ++nt)
#pragma unroll
      for (int r = 0; r < 16; ++r) {
        const int ir = 32 * w + crow(r, h), pc = 32 * nt + c;
        const float y = Y1[nt][r] + Dk * bf2f(sXT[pc * 136 + ir]);
        Y[(size_t)(t0 + ir) * LDA + head * 64 + pc] = f2bf(y);
      }
#pragma unroll
    for (int mt = 0; mt < 2; ++mt)
#pragma unroll
      for (int r = 0; r < 16; ++r) S[mt][r] *= dec;
#pragma unroll
    for (int ks = 0; ks < 8; ++ks) {
#pragma unroll
      for (int mt = 0; mt < 2; ++mt) {
        const bf16x8 af = *(const bf16x8*)(sXS + (32 * mt + c) * 136 + ks * 16 + 8 * h);
        S[mt] = MFMA(af, btf[ks], S[mt]);
      }
    }
    __syncthreads();
#pragma unroll
    for (int mt = 0; mt < 2; ++mt)
#pragma unroll
      for (int r = 0; r < 16; ++r) sHS[(32 * mt + crow(r, h)) * 136 + 32 * w + c] = f2bf(S[mt][r]);
  }
  if (!lat) {
    float* o = OUTP(p) + (dir ? O_SB : O_SF) + ((size_t)((sidx * 4 + l) * 16 + head) * 64) * 128;
#pragma unroll
    for (int mt = 0; mt < 2; ++mt)
#pragma unroll
      for (int r = 0; r < 16; ++r) o[(size_t)(32 * mt + crow(r, h)) * 128 + 32 * w + c] = S[mt][r];
  }
  __syncthreads();
}

DI void attn_item(const Params& p, int l, int item) {
  const int tid = TID(), lane = tid & 63, w = __builtin_amdgcn_readfirstlane(tid >> 6), h = lane >> 5, c = lane & 31;
  int hh, t0, Lk, krow0, pos0; size_t vbase; bool lat;
  if (item < 1024) { const int b = item >> 8; hh = (item >> 5) & 7; const int qb = item & 31; lat = true; t0 = TC + b * 4096 + qb * 128; Lk = LKL; krow0 = b * LKL; vbase = (size_t)b * 512 * LKL; pos0 = qb * 128; }
  else { const int it = item - 1024; const int s = it >> 4; hh = (it >> 1) & 7; const int qb = it & 1; lat = false; t0 = s * 256 + qb * 128; Lk = 256; krow0 = KROW_CTX + s * 256; vbase = (size_t)4 * 512 * LKL + (size_t)s * 512 * 256; pos0 = 0; }
  const u16* Q = (const u16*)(WSP(p) + WS_Q); const u16* KN = (const u16*)(WSP(p) + WS_KN); const u16* KRA = (const u16*)(WSP(p) + WS_KR);
  const u16* VT = (const u16*)(WSP(p) + WS_VT) + vbase + (size_t)hh * 64 * Lk;
  u16* YC = (u16*)(WSP(p) + WS_YC);
  u16* sK = (u16*)smem;
  u16* sV = sK + 2 * 64 * 104;
  bf16x8 qf[6];
  {
    const int tq = t0 + 32 * w + c;
    const u16* qrow = Q + (size_t)tq * 768 + hh * 96 + 8 * h;
    float f[6][8];
#pragma unroll
    for (int s = 0; s < 6; ++s) unpack8(*(const u32x4*)(qrow + 16 * s), f[s]);
    if (lat) {
      const int pos = pos0 + 32 * w + c;
#pragma unroll
      for (int e = 0; e < 8; ++e) {
        const int ii = 8 * h + e;
        const float pp = (ii < 8) ? (float)(pos >> 6) : (float)(pos & 63);
        const float inv = exp2f(-(float)(ii & 7) * (13.287712379549449f / 8.f));
        const float ang = pp * inv;
        const float cs = cosf(ang), sn = sinf(ang);
        const float x1 = f[4][e], x2 = f[5][e];
        f[4][e] = x1 * cs - x2 * sn; f[5][e] = x1 * sn + x2 * cs;
      }
    }
    const float sc = 0.10206207261596575f * 1.4426950408889634f;
#pragma unroll
    for (int s = 0; s < 6; ++s) {
#pragma unroll
      for (int e = 0; e < 8; ++e) f[s][e] *= sc;
      qf[s] = __builtin_bit_cast(bf16x8, pack8(f[s]));
    }
  }
  f32x16 O[2];
#pragma unroll
  for (int vt = 0; vt < 2; ++vt)
#pragma unroll
    for (int r = 0; r < 16; ++r) O[vt][r] = 0.f;
  float m_run = -1e30f, l_run = 0.f;
  const int ntile = Lk >> 6;
  u32x4 rk[3], rv[2];
  auto gload = [&](int kt) {
    const int key0 = kt * 64;
#pragma unroll
    for (int q = 0; q < 3; ++q) {
      const int id = tid + 256 * q, key = id / 12, cc = id - key * 12;
      const size_t kr = (size_t)(krow0 + key0 + key);
      rk[q] = cc < 8 ? *(const u32x4*)(KN + kr * 512 + hh * 64 + cc * 8) : *(const u32x4*)(KRA + kr * 32 + (cc - 8) * 8);
    }
#pragma unroll
    for (int q = 0; q < 2; ++q) {
      const int id = tid + 256 * q, v = id >> 3, cc = id & 7;
      rv[q] = *(const u32x4*)(VT + (size_t)v * Lk + key0 + cc * 8);
    }
  };
  auto sstore = [&](int buf) {
#pragma unroll
    for (int q = 0; q < 3; ++q) {
      const int id = tid + 256 * q, key = id / 12, cc = id - key * 12;
      *(u32x4*)(sK + buf * 64 * 104 + key * 104 + cc * 8) = rk[q];
    }
#pragma unroll
    for (int q = 0; q < 2; ++q) {
      const int id = tid + 256 * q, v = id >> 3, cc = id & 7;
      u16* d = sV + buf * 64 * 68 + v * 68 + cc * 8;
      u32x2 lo = {rv[q][0], rv[q][1]}, hi = {rv[q][2], rv[q][3]};
      *(u32x2*)d = lo; *(u32x2*)(d + 4) = hi;
    }
  };
  gload(0);
  __syncthreads();
  sstore(0);
  __syncthreads();
  for (int kt = 0; kt < ntile; ++kt) {
    const int cur = kt & 1;
    if (kt + 1 < ntile) gload(kt + 1);
    f32x16 Sx[2];
#pragma unroll
    for (int k2 = 0; k2 < 2; ++k2) {
#pragma unroll
      for (int r = 0; r < 16; ++r) Sx[k2][r] = 0.f;
      const u16* kp = sK + cur * 64 * 104 + (32 * k2 + c) * 104 + 8 * h;
#pragma unroll
      for (int s = 0; s < 6; ++s) Sx[k2] = MFMA(*(const bf16x8*)(kp + 16 * s), qf[s], Sx[k2]);
    }
    float mx = Sx[0][0];
#pragma unroll
    for (int k2 = 0; k2 < 2; ++k2)
#pragma unroll
      for (int r = 0; r < 16; ++r) mx = fmaxf(mx, Sx[k2][r]);
    mx = fmaxf(mx, __shfl_xor(mx, 32));
    const float m_new = fmaxf(m_run, mx);
    const float alpha = __builtin_amdgcn_exp2f(m_run - m_new);
    m_run = m_new;
    float ls = 0.f;
#pragma unroll
    for (int k2 = 0; k2 < 2; ++k2)
#pragma unroll
      for (int r = 0; r < 16; ++r) { const float pv = __builtin_amdgcn_exp2f(Sx[k2][r] - m_new); Sx[k2][r] = pv; ls += pv; }
    l_run = l_run * alpha + ls;
#pragma unroll
    for (int vt = 0; vt < 2; ++vt)
#pragma unroll
      for (int r = 0; r < 16; ++r) O[vt][r] *= alpha;
#pragma unroll
    for (int k2 = 0; k2 < 2; ++k2)
#pragma unroll
      for (int s2 = 0; s2 < 2; ++s2) {
        u32x4 pp;
        pp[0] = pk2(Sx[k2][8 * s2 + 0], Sx[k2][8 * s2 + 1]); pp[1] = pk2(Sx[k2][8 * s2 + 2], Sx[k2][8 * s2 + 3]);
        pp[2] = pk2(Sx[k2][8 * s2 + 4], Sx[k2][8 * s2 + 5]); pp[3] = pk2(Sx[k2][8 * s2 + 6], Sx[k2][8 * s2 + 7]);
        const bf16x8 pf = __builtin_bit_cast(bf16x8, pp);
#pragma unroll
        for (int vt = 0; vt < 2; ++vt) {
          const u16* vp = sV + cur * 64 * 68 + (32 * vt + c) * 68 + 32 * k2 + 16 * s2 + 4 * h;
          const u32x2 lo = *(const u32x2*)vp, hi = *(const u32x2*)(vp + 8);
          u32x4 vv = {lo[0], lo[1], hi[0], hi[1]};
          O[vt] = MFMA(__builtin_bit_cast(bf16x8, vv), pf, O[vt]);
        }
      }
    if (kt + 1 < ntile) sstore(cur ^ 1);
    __syncthreads();
  }
  const float lt = l_run + __shfl_xor(l_run, 32);
  const float invl = 1.f / lt;
  const int tq = t0 + 32 * w + c;
#pragma unroll
  for (int vt = 0; vt < 2; ++vt)
#pragma unroll
    for (int g = 0; g < 4; ++g) {
      u32x2 pk; pk[0] = pk2(O[vt][4 * g] * invl, O[vt][4 * g + 1] * invl); pk[1] = pk2(O[vt][4 * g + 2] * invl, O[vt][4 * g + 3] * invl);
      *(u32x2*)(YC + (size_t)tq * 512 + hh * 64 + 32 * vt + 8 * g + 4 * h) = pk;
    }
}

DI void l5_phase(const Params& p, int l, int rep = 0) {
  u32* ctr = (u32*)(WSP(p) + WS_CTR) + l + 8 * rep;
  int* sitem = (int*)(smem + 73728 - 16);
  constexpr int NITEMS = 128 + 1024 + 256 + 512;
  while (true) {
    __syncthreads();
    if (TID() == 0) *sitem = (int)atomicAdd(ctr, 1u);
    __syncthreads();
    const int it = *sitem;
    if (it >= NITEMS) break;
    if (it < 128) ssd_unit(p, l, it);
    else if (it < 128 + 1280) attn_item(p, l, it - 128);
    else ssd_unit(p, l, it - 1280);
  }
}

DI void l5b_phase(const Params& p, int l) {
  u16* ACT = (u16*)(WSP(p) + WS_ACT);
  float* RB = (float*)(WSP(p) + WS_RB);
  const int lane = TID() & 63, gw = BID() * 4 + (TID() >> 6), nwv = gridDim.x * 4;
  for (int t = gw; t < T; t += nwv) {
    u16* row = ACT + (size_t)t * LDA;
    float ss = 0.f;
#pragma unroll
    for (int q = 0; q < 2; ++q) {
      const int c8 = (lane + 64 * q) * 8;
      float yf[8], yb[8], z[8], o[8];
      unpack8(*(const u32x4*)(row + C_YF + c8), yf); unpack8(*(const u32x4*)(row + C_YB + c8), yb); unpack8(*(const u32x4*)(row + C_Z + c8), z);
#pragma unroll
      for (int e = 0; e < 8; ++e) { o[e] = (yf[e] + yb[e]) * silu_f(z[e]); ss += o[e] * o[e]; }
      *(u32x4*)(row + C_YF + c8) = pack8(o);
    }
    ss = wave_sum(ss);
    if (lane == 0) RB[t] = rsqrtf(ss * (1.f / 1024.f) + EPS);
  }
}

DI int gate_col(int n) { return n < 2048 ? n : 3584 + (n - 2048); }
DI void l6a_phase(const Params& p, int l, int& nbar) {
  constexpr int NT = 24, MT = 80;
  TILE_LOOP(MT * NT) {
    group_sync(p, nbar);
    if (idx >= MT * NT) continue;
    int mt, nt; decode_tile(idx, NT, mt, nt);
    const u16* W = (const u16*)(WSP(p) + WS_W) + W_GATE;
    const u16* H = (const u16*)(WSP(p) + WS_H);
    u16* ACT = (u16*)(WSP(p) + WS_ACT);
    f32x16 acc[8];
#pragma unroll
    for (int j = 0; j < 8; ++j)
#pragma unroll
      for (int r = 0; r < 16; ++r) acc[j][r] = 0.f;
    gemm_tile_wf8(W, 1024, nt * 128, H + (size_t)mt * 256 * 1024, 1024, acc);
    const int m0 = mt * 256, gc0 = gate_col(nt * 128);
    stage_bf16_w8([&](int j, int r) { return sigmoid_f(acc[j][r]); });
    copy_out_bf16_256x128(ACT + (size_t)m0 * LDA + gc0, LDA, 128);
  }
}
DI void l6b_phase(const Params& p, int l, int& nbar) {
  TILE_LOOP(160 * 8) {
    group_sync(p, nbar);
    if (idx >= 160 * 8) continue;
    int mt, nt; decode_tile(idx, 8, mt, nt);
    const int m0 = mt * 128, n0 = nt * 128;
    u32 Mp[2][2][8];
#pragma unroll
    for (int i = 0; i < 2; ++i)
#pragma unroll
      for (int j = 0; j < 2; ++j)
#pragma unroll
        for (int r = 0; r < 8; ++r) Mp[i][j][r] = 0u;
#pragma unroll 1
    for (int br = 0; br < 3; ++br) {
      const u16* W = (const u16*)(WSP(p) + WS_W);
      const u16* ACT = (const u16*)(WSP(p) + WS_ACT);
      f32x16 acc[2][2]; zero_acc(acc);
      const u16* Ab; const u16* Wb; int ldab, Kb;
      if (br == 0) { Ab = (const u16*)(WSP(p) + WS_YA) + (size_t)m0 * 512; ldab = 512; Wb = W + W_A + (size_t)n0 * 512; Kb = 512; }
      else if (br == 1) { Ab = ACT + (size_t)m0 * LDA + C_YF; ldab = LDA; Wb = W + W_B + (size_t)n0 * 1024; Kb = 1024; }
      else { Ab = (const u16*)(WSP(p) + WS_YC) + (size_t)m0 * 512; ldab = 512; Wb = W + W_C + (size_t)n0 * 512; Kb = 512; }
      gemm_tile(Wb, Kb, Ab, ldab, Kb, acc);
      const float* RB = (const float*)(WSP(p) + WS_RB);
      const int tid3 = TID(), lane3 = tid3 & 63, w3 = tid3 >> 6;
      const int wm = w3 >> 1, h = lane3 >> 5, wn = w3 & 1, c = lane3 & 31;
      const int gc0 = gate_col(br * 1024 + n0);
      u16* sG = (u16*)smem;
#pragma unroll
      for (int q = 0; q < 8; ++q) {
        const int id = tid3 + 256 * q, row = id >> 4, cc = id & 15;
        *(u32x4*)(sG + row * 136 + cc * 8) = *(const u32x4*)(ACT + (size_t)(m0 + row) * LDA + gc0 + cc * 8);
      }
      __syncthreads();
#pragma unroll
      for (int j = 0; j < 2; ++j) {
        const int ml = wn * 64 + j * 32 + c;
        const float rb = (br == 1) ? RB[m0 + ml] : 1.f;
#pragma unroll
        for (int i = 0; i < 2; ++i)
#pragma unroll
          for (int g = 0; g < 4; ++g) {
            const u32x2 gv = *(const u32x2*)(sG + ml * 136 + wm * 64 + i * 32 + 8 * g + 4 * h);
            const float v0 = acc[i][j][4 * g] * rb, v1 = acc[i][j][4 * g + 1] * rb, v2 = acc[i][j][4 * g + 2] * rb, v3 = acc[i][j][4 * g + 3] * rb;
            Mp[i][j][2 * g] = pk2(bflo(Mp[i][j][2 * g]) + bflo(gv[0]) * v0, bfhi(Mp[i][j][2 * g]) + bfhi(gv[0]) * v1);
            Mp[i][j][2 * g + 1] = pk2(bflo(Mp[i][j][2 * g + 1]) + bflo(gv[1]) * v2, bfhi(Mp[i][j][2 * g + 1]) + bfhi(gv[1]) * v3);
          }
      }
    }
    {
      u16* MG = (u16*)(WSP(p) + WS_XT);
      u16* sC = (u16*)smem;
      const int tid4 = TID(), lane4 = tid4 & 63, w4 = tid4 >> 6;
      const int wm = w4 >> 1, h = lane4 >> 5, wn = w4 & 1, c = lane4 & 31;
      __syncthreads();
#pragma unroll
      for (int i = 0; i < 2; ++i)
#pragma unroll
        for (int j = 0; j < 2; ++j)
#pragma unroll
          for (int g = 0; g < 4; ++g) {
            u32x2 pk; pk[0] = Mp[i][j][2 * g]; pk[1] = Mp[i][j][2 * g + 1];
            *(u32x2*)(sC + (wn * 64 + j * 32 + c) * 136 + wm * 64 + i * 32 + 8 * g + 4 * h) = pk;
          }
      __syncthreads();
      copy_out_bf16<128>(MG + (size_t)m0 * 1024 + n0, 1024, 128);
    }
  }
}

DI void resid_gemm_phase(const Params& p, int l, const u16* A, int lda, const u16* Wm, int K, int gidx, int& nbar) {
  float* X = OUTP(p);
  const float* MOD = (const float*)(WSP(p) + WS_MOD) + (size_t)l * 5 * 6144 + gidx * 1024;
  constexpr int NFULL = 1280, NITEM = 1280;
  TILE_LOOP(NITEM) {
    group_sync(p, nbar);
    if (idx >= NITEM) continue;
    const bool split = idx >= NFULL;
    const int tile = split ? NFULL + ((idx - NFULL) >> 1) : idx;
    const int half = split ? ((idx - NFULL) & 1) : 0;
    const int Kp = split ? (K >> 1) : K;
    int mt, nt; decode_tile(tile, 8, mt, nt);
    const int m0 = mt * 128, n0 = nt * 128;
    f32x16 acc[4];
#pragma unroll
    for (int j = 0; j < 4; ++j)
#pragma unroll
      for (int r = 0; r < 16; ++r) acc[j][r] = 0.f;
    gemm_tile_wf4(Wm, K, n0, A + (size_t)m0 * lda + half * Kp, lda, acc, Kp, (half * Kp) >> 4);
    const float* gt = MOD + tile_cb(mt) * 6144 + n0;
    stage_f32_w4(acc);
    {
      const float* sC = (const float*)smem;
      const int tid = TID(), cc = tid & 31;
      const f4 g4 = *(const f4*)(gt + cc * 4);
#pragma unroll 4
      for (int q = 0; q < 16; ++q) {
        const int row = (tid >> 5) + 8 * q;
        const f4 v = *(const f4*)(sC + row * 132 + cc * 4);
        float* xp = X + (size_t)(m0 + row) * 1024 + n0 + cc * 4;
        if (!split) { f4 x = *(const f4*)xp; x[0] += g4[0] * v[0]; x[1] += g4[1] * v[1]; x[2] += g4[2] * v[2]; x[3] += g4[3] * v[3]; *(f4*)xp = x; }
        else { atomicAdd(xp, g4[0] * v[0]); atomicAdd(xp + 1, g4[1] * v[1]); atomicAdd(xp + 2, g4[2] * v[2]); atomicAdd(xp + 3, g4[3] * v[3]); }
      }
    }
  }
}

template <int MODE = 0>
DI void l9_phase(const Params& p, int l, int& nbar) {
  const u16* W = (const u16*)(WSP(p) + WS_W) + W_F13;
  const u16* H = (const u16*)(WSP(p) + WS_H);
  u16* ACT = (u16*)(WSP(p) + WS_ACT);
  constexpr int NT = 44, MT = 80;
  TILE_LOOP(MT * NT) {
    group_sync(p, nbar);
    if (idx >= MT * NT) continue;
    int mt, nt; decode_tile(idx, NT, mt, nt);
    f32x16 acc[8];
#pragma unroll
    for (int j = 0; j < 8; ++j)
#pragma unroll
      for (int r = 0; r < 16; ++r) acc[j][r] = 0.f;
    gemm_tile_wf8(W, 1024, nt * 128, H + (size_t)mt * 256 * 1024, 1024, acc);
    stage_bf16_w8u([&](int j, int r) { return silu_f(acc[j][r]) * acc[j][r + 8]; });
    if (MODE == 0) copy_out_bf16_256x64(ACT + (size_t)mt * 256 * LDA + C_U + nt * 64, LDA);
  }
}

DI void final_phase(const Params& p) {
  float* X = OUTP(p);
  const float* nw = INP(p, I_FNW);
  const int lane = TID() & 63, gw = BID() * 4 + (TID() >> 6), nwv = gridDim.x * 4;
  for (int t = gw; t < T; t += nwv) {
    f4* xr = (f4*)(X + (size_t)t * 1024) + lane;
    f4 v[4]; float s = 0.f;
#pragma unroll
    for (int j = 0; j < 4; ++j) { v[j] = xr[64 * j]; s += v[j][0] * v[j][0] + v[j][1] * v[j][1] + v[j][2] * v[j][2] + v[j][3] * v[j][3]; }
    const float rstd = rsqrtf(wave_sum(s) * (1.f / 1024.f) + EPS);
#pragma unroll
    for (int j = 0; j < 4; ++j) {
      const f4 wv = *(const f4*)(nw + 4 * lane + 256 * j);
      f4 o; o[0] = v[j][0] * rstd * wv[0]; o[1] = v[j][1] * rstd * wv[1]; o[2] = v[j][2] * rstd * wv[2]; o[3] = v[j][3] * rstd * wv[3];
      xr[64 * j] = o;
    }
  }
}

constexpr int NPH_LAYER = 11;
constexpr int NPHASE = 1 + NLAYER * NPH_LAYER + 1;

DI void run_phase(const Params& p, int ph) {
  int nbar = 0;
  if (ph == 0) { pre_phase(p); return; }
  if (ph == NPHASE - 1) { final_phase(p); return; }
  const int l = (ph - 1) / NPH_LAYER, s = (ph - 1) % NPH_LAYER;
  const u16* W = (const u16*)(WSP(p) + WS_W);
  const u16* ACT = (const u16*)(WSP(p) + WS_ACT);
  switch (s) {
    case 0: l1_phase(p, l); break;
    case 1: l2_phase(p, l, nbar); break;
    case 2: l3_phase(p, l); break;
    case 3: l4_phase(p, l, nbar); break;
    case 4: l5_phase(p, l); break;
    case 5: l5b_phase(p, l); break;
    case 6: l6a_phase(p, l, nbar); l6b_phase(p, l, nbar); break;
    case 7: resid_gemm_phase(p, l, (const u16*)(WSP(p) + WS_XT), 1024, W + W_O, 1024, 2, nbar); break;
    case 8: norm_phase(p, l, 1); break;
    case 9: l9_phase(p, l, nbar); break;
    case 10: resid_gemm_phase(p, l, ACT + C_U, LDA, W + W_F2, FF, 5, nbar); break;
  }
}

__global__ void __launch_bounds__(256, 2) fwd_kernel(Params p) {
#if MULTI
  run_phase(p, p.ph_lo);
#else
  cg::grid_group grid = cg::this_grid();
  if (threadIdx.x == 0) xb_words = make_uint4(0u, 0u, 0u, 0u);
  __syncthreads();
  if (threadIdx.x == 0) (void)xb_add(&((unsigned*)(WSP(p) + WS_BAR))[XB_XCNT(xb_xcc_id())], 1u);
  if (p.ph_lo < 0) grid.sync();
  int nbar = 0;
  pre_phase(p); gsync(p);
#pragma unroll 1
  for (int l = 0; l < NLAYER; ++l) {
    l1_phase(p, l); gsync(p);
    if (PROBE_DUP == 1) { l1_phase(p, l); gsync(p); }
    l2_phase(p, l, nbar); gsync(p);
    if (PROBE_DUP == 2) { l2_phase(p, l, nbar); gsync(p); }
    l3_phase(p, l); l3d_phase(p, l); gsync(p);
    if (PROBE_DUP == 3) { l3_phase(p, l); gsync(p); }
    l4_phase(p, l, nbar); gsync(p);
    if (PROBE_DUP == 4) { l4_phase(p, l, nbar); gsync(p); }
    l5_phase(p, l); gsync(p);
    if (PROBE_DUP == 5) { l5_phase(p, l, 1); gsync(p); }
    l5b_phase(p, l); gsync(p);
    l6a_phase(p, l, nbar); gsync(p);
    l6b_phase(p, l, nbar); gsync(p);
    resid_gemm_phase(p, l, (const u16*)(WSP(p) + WS_XT), 1024, (const u16*)(WSP(p) + WS_W) + W_O, 1024, 2, nbar); gsync(p);
    norm_phase(p, l, 1); gsync(p);
    l9_phase(p, l, nbar); gsync(p);
    if (PROBE_DUP == 9) { l9_phase<GEMM_MODE_PROBE>(p, l, nbar); gsync(p); }
    resid_gemm_phase(p, l, (const u16*)(WSP(p) + WS_ACT) + C_U, LDA, (const u16*)(WSP(p) + WS_W) + W_F2, FF, 5, nbar); gsync(p);
  }
  final_phase(p);
#endif
}

extern "C" void kernel_launch(void* const* d_in, const int* in_sizes, int n_in, void* d_out, int out_size, void* d_ws, size_t ws_size,
                              hipStream_t stream) {
  static int grid_blocks = 0;
  if (!grid_blocks) {
    int dev = 0, cus = 0, per_cu = 0;
    hipGetDevice(&dev);
    hipDeviceGetAttribute(&cus, hipDeviceAttributeMultiprocessorCount, dev);
    hipOccupancyMaxActiveBlocksPerMultiprocessor(&per_cu, fwd_kernel, 256, 0);
    per_cu = 2;
    grid_blocks = cus * per_cu;
    if (ws_size < WS_END || n_in != 32) { fprintf(stderr, "kernel_launch: ws too small (%zu < %zu) or n_in %d\n", ws_size, (size_t)WS_END, n_in); grid_blocks = -1; }
  }
  if (grid_blocks < 0) return;
  Params p{};
  for (int i = 0; i < 32; ++i) p.in[i] = (const float*)d_in[i];
  p.in[32] = (const float*)d_out;
  p.in[33] = (const float*)d_ws;
#if MULTI
  for (int ph = 0; ph < NPHASE; ++ph) {
    p.ph_lo = ph; p.ph_hi = ph + 1;
    hipLaunchKernelGGL(fwd_kernel, dim3(grid_blocks), dim3(256), 0, stream, p);
  }
#else
  p.ph_lo = 0; p.ph_hi = NPHASE;
  (void)hipMemsetAsync((char*)d_ws + WS_BAR, 0, 16384, stream);
  void* args[] = {&p};
  hipError_t e = hipLaunchCooperativeKernel((void*)fwd_kernel, dim3(grid_blocks), dim3(256), args, 0, stream);
  if (e != hipSuccess) fprintf(stderr, "cooperative launch failed: %s (grid %d)\n", hipGetErrorString(e), grid_blocks);
#endif
}
```

```cpp
#include <hip/hip_runtime.h>
#include <hip/hip_cooperative_groups.h>
#include <cstdio>
namespace cg = cooperative_groups;

#ifndef PROBE_DUP
#define PROBE_DUP 0
#endif
#ifndef USE_GSYNC
#define USE_GSYNC 0
#endif
#ifndef GEMM_MODE_PROBE
#define GEMM_MODE_PROBE 1
#endif
#ifndef MULTI
#define MULTI 0
#endif

#define DI __device__ __forceinline__
typedef unsigned short u16;
typedef unsigned int u32;
using bf16x8 = __attribute__((ext_vector_type(8))) short;
using f32x16 = __attribute__((ext_vector_type(16))) float;
using u32x4 = __attribute__((ext_vector_type(4))) unsigned;
using u32x2 = __attribute__((ext_vector_type(2))) unsigned;
using f4 = __attribute__((ext_vector_type(4))) float;
typedef __bf16 bf2_t __attribute__((ext_vector_type(2)));
typedef float f2_t __attribute__((ext_vector_type(2)));
#define MFMA(a, b, c) __builtin_amdgcn_mfma_f32_32x32x16_bf16((a), (b), (c), 0, 0, 0)

constexpr int D = 1024, T = 20480, TC = 4096, NLAYER = 4;
constexpr int NPROJ = 4656, INC = 7728, FF = 2816;
constexpr int LDA = 4672;
constexpr int C_AX = 0, C_AB = 512, C_AC = 1024, C_Z = 1536, C_XBC = 2560, C_DT = 4096, C_CQ = 4112, C_CKV = 4368, C_KR = 4624;
constexpr int C_YF = C_XBC, C_YB = 0, C_MERGED = 0, C_U = 0;
constexpr int NKROW = 22528, KROW_CTX = 18432, LKL = 4608;
constexpr float EPS = 1e-6f;

constexpr size_t W_IN = 0;
constexpr size_t W_GATE = W_IN + (size_t)4736 * 1024;
constexpr size_t W_A = W_GATE + (size_t)3072 * 1024;
constexpr size_t W_B = W_A + 1024 * 512;
constexpr size_t W_UQ = W_B + 1024 * 1024;
constexpr size_t W_UKV = W_UQ + 768 * 256;
constexpr size_t W_C = W_UKV + 1024 * 256;
constexpr size_t W_O = W_C + 1024 * 512;
constexpr size_t W_F13 = W_O + 1024 * 1024;
constexpr size_t W_F2 = W_F13 + (size_t)2 * FF * 1024;
constexpr size_t W_END = W_F2 + (size_t)1024 * FF;

constexpr size_t al256(size_t x) { return (x + 255) & ~(size_t)255; }
constexpr size_t WS_W = 0;
constexpr size_t WS_ACT = al256(WS_W + W_END * 2);
constexpr size_t WS_H = al256(WS_ACT + (size_t)T * LDA * 2);
constexpr size_t WS_XT = al256(WS_H + (size_t)T * 1024 * 2);
constexpr size_t WS_BCP = al256(WS_XT + (size_t)T * 1024 * 2);
constexpr size_t WS_BT = al256(WS_BCP + (size_t)T * 512 * 2);
constexpr size_t WS_YA = al256(WS_BT + (size_t)160 * 256 * 128 * 2);
constexpr size_t WS_YC = al256(WS_YA + (size_t)T * 512 * 2);
constexpr size_t WS_Q = al256(WS_YC + (size_t)T * 512 * 2);
constexpr size_t WS_KN = al256(WS_Q + (size_t)T * 768 * 2);
constexpr size_t WS_VT = al256(WS_KN + (size_t)NKROW * 512 * 2);
constexpr size_t WS_KR = al256(WS_VT + (size_t)NKROW * 512 * 2);
constexpr size_t WS_CKVA = al256(WS_KR + (size_t)NKROW * 32 * 2);
constexpr size_t WS_CB = al256(WS_CKVA + (size_t)NKROW * 256 * 2);
constexpr size_t WS_DT = al256(WS_CB + (size_t)320 * 128 * 128 * 2);
constexpr size_t WS_RQ = al256(WS_DT + (size_t)T * 16 * 4);
constexpr size_t WS_RB = al256(WS_RQ + (size_t)T * 4);
constexpr size_t WS_MOD = al256(WS_RB + (size_t)T * 4);
constexpr size_t WS_CTR = al256(WS_MOD + (size_t)NLAYER * 5 * 6144 * 4);
constexpr size_t WS_CUMS = al256(WS_CTR + 4096);
constexpr size_t WS_BAR = al256(WS_CUMS + (size_t)160 * 2 * 16 * 768 * 4);
constexpr size_t WS_END = WS_BAR + 16384;

constexpr size_t O_CKV = 20971520, O_KR = 25165824, O_SF = 25690112, O_SB = 34078720;

struct Params {
  const float* in[34];
  int ph_lo, ph_hi;
};
enum { I_XP = 0, I_XS, I_C, I_CCKV, I_CKR, I_STF, I_STB, I_CCTX, I_WIN, I_ACW, I_WAO, I_SCW, I_SCB, I_ALOG, I_DTB, I_SD, I_SNW, I_WBO,
       I_QNW, I_WUQ, I_KVNW, I_WUKV, I_WCO, I_WO, I_WADA, I_BADA, I_N1, I_N2, I_F1, I_F3, I_F2, I_FNW };

DI int TID() { int t = threadIdx.x; asm volatile("" : "+v"(t)); return t; }
DI int BID() { int b = blockIdx.x; asm volatile("" : "+s"(b)); return b; }
DI const float* KARG(int i) {
  unsigned long long kp = (unsigned long long)__builtin_amdgcn_kernarg_segment_ptr();
  asm volatile("" : "+s"(kp));
  typedef __attribute__((address_space(4))) const unsigned long long* karg_ptr_t;
  typedef __attribute__((address_space(1))) const float* gptr_t;
  return (const float*)(gptr_t)(((karg_ptr_t)kp)[i]);
}
DI unsigned char* WSP(const Params& p) { return (unsigned char*)KARG(33); }
DI float* OUTP(const Params& p) { return (float*)KARG(32); }
DI const float* INP(const Params& p, int i) { return KARG(i); }
DI float bf2f(u16 v) { return __uint_as_float((u32)v << 16); }
DI float bflo(u32 v) { return __uint_as_float(v << 16); }
DI float bfhi(u32 v) { return __uint_as_float(v & 0xffff0000u); }
DI u32 pk2(float a, float b) { f2_t v = {a, b}; bf2_t r = __builtin_convertvector(v, bf2_t); return __builtin_bit_cast(u32, r); }
DI u16 f2bf(float a) { return (u16)(pk2(a, 0.f) & 0xffffu); }
DI float silu_f(float x) { return x / (1.f + __expf(-x)); }
DI float sigmoid_f(float x) { return 1.f / (1.f + __expf(-x)); }
DI float wave_sum(float v) {
#pragma unroll
  for (int o = 1; o < 64; o <<= 1) v += __shfl_xor(v, o);
  return v;
}
DI int crow(int r, int h) { return (r & 3) + 8 * (r >> 2) + 4 * h; }
DI int tile_cb(int mt) { return mt < 32 ? 0 : 1 + ((mt - 32) >> 5); }

__shared__ __attribute__((aligned(16))) unsigned char smem[73728];

template <int MODE = 0>
DI void gemm_tile(const u16* A, int lda, const u16* B, int ldb, int K, f32x16 (&acc)[2][2]) {
  u16* sA = (u16*)smem;
  u16* sB = sA + 2 * 128 * 72;
  const int tid = TID(), lane = tid & 63, w = tid >> 6, wm = w >> 1, wn = w & 1;
  const int lr = tid >> 3, lc = (tid & 7) * 8;
  const u16* ga = A + (size_t)lr * lda + lc;
  const u16* gb = B + (size_t)lr * ldb + lc;
  u32x4 ra[4], rb[4];
#pragma unroll
  for (int p = 0; p < 4; ++p) { ra[p] = *(const u32x4*)(ga + (size_t)(32 * p) * lda); rb[p] = *(const u32x4*)(gb + (size_t)(32 * p) * ldb); }
  __syncthreads();
#pragma unroll
  for (int p = 0; p < 4; ++p) { *(u32x4*)(sA + (lr + 32 * p) * 72 + lc) = ra[p]; *(u32x4*)(sB + (lr + 32 * p) * 72 + lc) = rb[p]; }
  __syncthreads();
  const int nk = K >> 6;
  const int fo_a = (wm * 64 + (lane & 31)) * 72 + (lane >> 5) * 8;
  const int fo_b = (wn * 64 + (lane & 31)) * 72 + (lane >> 5) * 8;
  for (int kt = 0; kt < nk; ++kt) {
    const int cur = kt & 1;
    if (kt + 1 < nk) {
      const int k0 = (kt + 1) * 64;
#pragma unroll
      for (int p = 0; p < 4; ++p) { ra[p] = *(const u32x4*)(ga + (size_t)(32 * p) * lda + k0); rb[p] = *(const u32x4*)(gb + (size_t)(32 * p) * ldb + k0); }
    }
    const u16* pa = sA + cur * 128 * 72 + fo_a;
    const u16* pb = sB + cur * 128 * 72 + fo_b;
#pragma unroll
    for (int ks = 0; ks < 4; ++ks) {
      bf16x8 a0 = *(const bf16x8*)(pa + ks * 16), a1 = *(const bf16x8*)(pa + 32 * 72 + ks * 16);
      bf16x8 b0 = *(const bf16x8*)(pb + ks * 16), b1 = *(const bf16x8*)(pb + 32 * 72 + ks * 16);
      acc[0][0] = MFMA(a0, b0, acc[0][0]); acc[0][1] = MFMA(a0, b1, acc[0][1]);
      acc[1][0] = MFMA(a1, b0, acc[1][0]); acc[1][1] = MFMA(a1, b1, acc[1][1]);
    }
    if (kt + 1 < nk) {
      u16* da = sA + (cur ^ 1) * 128 * 72; u16* db = sB + (cur ^ 1) * 128 * 72;
#pragma unroll
      for (int p = 0; p < 4; ++p) { *(u32x4*)(da + (lr + 32 * p) * 72 + lc) = ra[p]; *(u32x4*)(db + (lr + 32 * p) * 72 + lc) = rb[p]; }
    }
    __syncthreads();
  }
}

template <int MODE = 0>
DI void gemm_tile_wf(const u16* Wfm, int K, int nrow0, const u16* Act, int ldact, f32x16 (&acc)[2][2]) {
  u16* sB = (u16*)smem;
  const int tid = TID(), lane = tid & 63, w = tid >> 6, wm = w >> 1, wn = w & 1;
  const int lr = tid >> 3, lc = (tid & 7) * 8;
  const u16* gb = Act + (size_t)lr * ldact + lc;
  const size_t sb32 = (size_t)32 * ldact;
  const int kq = K >> 4;
  const u16* gw0 = Wfm + ((size_t)((nrow0 >> 5) + wm * 2) * kq) * 512 + lane * 8;
  const u16* gw1 = gw0 + (size_t)kq * 512;
  const int so = lr * 72 + lc;
  const int nk = K >> 6;
  u32x4 rb[4];
  bf16x8 wa[2][4], wb[2][4];
#pragma unroll
  for (int p = 0; p < 4; ++p) rb[p] = *(const u32x4*)(gb + p * sb32);
#pragma unroll
  for (int ks = 0; ks < 4; ++ks) { wa[0][ks] = *(const bf16x8*)(gw0 + ks * 512); wa[1][ks] = *(const bf16x8*)(gw1 + ks * 512); }
  __syncthreads();
#pragma unroll
  for (int p = 0; p < 4; ++p) *(u32x4*)(sB + so + 32 * 72 * p) = rb[p];
  __syncthreads();
  const int fo_b = (wn * 64 + (lane & 31)) * 72 + (lane >> 5) * 8;
  auto compute = [&](int cur, bf16x8 (&wf)[2][4]) {
    const u16* pb = sB + cur * 128 * 72 + fo_b;
#pragma unroll
    for (int ks = 0; ks < 4; ++ks) {
      const bf16x8 b0 = *(const bf16x8*)(pb + ks * 16), b1 = *(const bf16x8*)(pb + 32 * 72 + ks * 16);
      acc[0][0] = MFMA(wf[0][ks], b0, acc[0][0]); acc[0][1] = MFMA(wf[0][ks], b1, acc[0][1]);
      acc[1][0] = MFMA(wf[1][ks], b0, acc[1][0]); acc[1][1] = MFMA(wf[1][ks], b1, acc[1][1]);
    }
  };
  for (int kt = 0; kt < nk; kt += 2) {
    {
      const int k0 = (kt + 1) * 64;
#pragma unroll
      for (int p = 0; p < 4; ++p) rb[p] = *(const u32x4*)(gb + p * sb32 + k0);
#pragma unroll
      for (int ks = 0; ks < 4; ++ks) { wb[0][ks] = *(const bf16x8*)(gw0 + ((kt + 1) * 4 + ks) * 512); wb[1][ks] = *(const bf16x8*)(gw1 + ((kt + 1) * 4 + ks) * 512); }
    }
    compute(0, wa);
#pragma unroll
    for (int p = 0; p < 4; ++p) *(u32x4*)(sB + 128 * 72 + so + 32 * 72 * p) = rb[p];
    __syncthreads();
    {
      const int kn = (kt + 2 < nk) ? kt + 2 : nk - 1;
#pragma unroll
      for (int p = 0; p < 4; ++p) rb[p] = *(const u32x4*)(gb + p * sb32 + kn * 64);
#pragma unroll
      for (int ks = 0; ks < 4; ++ks) { wa[0][ks] = *(const bf16x8*)(gw0 + (kn * 4 + ks) * 512); wa[1][ks] = *(const bf16x8*)(gw1 + (kn * 4 + ks) * 512); }
    }
    compute(1, wb);
    if (kt + 2 < nk) {
#pragma unroll
      for (int p = 0; p < 4; ++p) *(u32x4*)(sB + so + 32 * 72 * p) = rb[p];
    }
    __syncthreads();
  }
}

DI void gemm_tile_wf4(const u16* Wfm, int K, int nrow0, const u16* Act, int ldact, f32x16 (&acc)[4], int Kp = 0, int ks0 = 0) {
  u16* sB = (u16*)smem;
  const int tid = TID(), lane = tid & 63, w = tid >> 6;
  const int lr = tid >> 3, lc = (tid & 7) * 8;
  const u16* gb = Act + (size_t)lr * ldact + lc;
  const size_t sb32 = (size_t)32 * ldact;
  const int kq = K >> 4;
  const u16* gw = Wfm + ((size_t)((nrow0 >> 5) + w) * kq + ks0) * 512 + lane * 8;
  const int so = lr * 72 + lc;
  const int nk = (Kp ? Kp : K) >> 6;
  u32x4 rb[4];
  bf16x8 wa[4], wb[4];
#pragma unroll
  for (int p = 0; p < 4; ++p) rb[p] = *(const u32x4*)(gb + p * sb32);
#pragma unroll
  for (int ks = 0; ks < 4; ++ks) wa[ks] = *(const bf16x8*)(gw + ks * 512);
  __syncthreads();
#pragma unroll
  for (int p = 0; p < 4; ++p) *(u32x4*)(sB + so + 32 * 72 * p) = rb[p];
  __syncthreads();
  const int fo_b = (lane & 31) * 72 + (lane >> 5) * 8;
  auto compute = [&](int cur, bf16x8 (&wf)[4]) {
    const u16* pb = sB + cur * 128 * 72 + fo_b;
#pragma unroll
    for (int ks = 0; ks < 4; ++ks) {
#pragma unroll
      for (int j = 0; j < 4; ++j) acc[j] = MFMA(wf[ks], *(const bf16x8*)(pb + j * 32 * 72 + ks * 16), acc[j]);
    }
  };
  for (int kt = 0; kt < nk; kt += 2) {
    {
      const int k0 = (kt + 1) * 64;
#pragma unroll
      for (int p = 0; p < 4; ++p) rb[p] = *(const u32x4*)(gb + p * sb32 + k0);
#pragma unroll
      for (int ks = 0; ks < 4; ++ks) wb[ks] = *(const bf16x8*)(gw + ((kt + 1) * 4 + ks) * 512);
    }
    compute(0, wa);
#pragma unroll
    for (int p = 0; p < 4; ++p) *(u32x4*)(sB + 128 * 72 + so + 32 * 72 * p) = rb[p];
    __syncthreads();
    {
      const int kn = (kt + 2 < nk) ? kt + 2 : nk - 1;
#pragma unroll
      for (int p = 0; p < 4; ++p) rb[p] = *(const u32x4*)(gb + p * sb32 + kn * 64);
#pragma unroll
      for (int ks = 0; ks < 4; ++ks) wa[ks] = *(const bf16x8*)(gw + (kn * 4 + ks) * 512);
    }
    compute(1, wb);
    if (kt + 2 < nk) {
#pragma unroll
      for (int p = 0; p < 4; ++p) *(u32x4*)(sB + so + 32 * 72 * p) = rb[p];
    }
    __syncthreads();
  }
}

DI void gemm_tile_wf8(const u16* Wfm, int K, int nrow0, const u16* Act, int ldact, f32x16 (&acc)[8]) {
  u16* sB = (u16*)smem;
  const int tid = TID(), lane = tid & 63, w = tid >> 6;
  const int lr = tid >> 3, lc = (tid & 7) * 8;
  const u16* gb = Act + (size_t)lr * ldact + lc;
  const size_t sb32 = (size_t)32 * ldact;
  const int kq = K >> 4;
  const u16* gw = Wfm + ((size_t)((nrow0 >> 5) + w) * kq) * 512 + lane * 8;
  const int so = lr * 72 + lc;
  const int nk = K >> 6;
  u32x4 rb[8];
  bf16x8 wa[4], wb[4];
#pragma unroll
  for (int p = 0; p < 8; ++p) rb[p] = *(const u32x4*)(gb + p * sb32);
#pragma unroll
  for (int ks = 0; ks < 4; ++ks) wa[ks] = *(const bf16x8*)(gw + ks * 512);
  __syncthreads();
#pragma unroll
  for (int p = 0; p < 8; ++p) *(u32x4*)(sB + so + 32 * 72 * p) = rb[p];
  __syncthreads();
  const int fo_b = (lane & 31) * 72 + (lane >> 5) * 8;
  auto compute = [&](int cur, bf16x8 (&wf)[4]) {
    const u16* pb = sB + cur * 256 * 72 + fo_b;
#pragma unroll
    for (int ks = 0; ks < 4; ++ks) {
#pragma unroll
      for (int j = 0; j < 8; ++j) acc[j] = MFMA(wf[ks], *(const bf16x8*)(pb + j * 32 * 72 + ks * 16), acc[j]);
    }
  };
  for (int kt = 0; kt < nk; kt += 2) {
    {
      const int k0 = (kt + 1) * 64;
#pragma unroll
      for (int p = 0; p < 8; ++p) rb[p] = *(const u32x4*)(gb + p * sb32 + k0);
#pragma unroll
      for (int ks = 0; ks < 4; ++ks) wb[ks] = *(const bf16x8*)(gw + ((kt + 1) * 4 + ks) * 512);
    }
    compute(0, wa);
#pragma unroll
    for (int p = 0; p < 8; ++p) *(u32x4*)(sB + 256 * 72 + so + 32 * 72 * p) = rb[p];
    __syncthreads();
    {
      const int kn = (kt + 2 < nk) ? kt + 2 : nk - 1;
#pragma unroll
      for (int p = 0; p < 8; ++p) rb[p] = *(const u32x4*)(gb + p * sb32 + kn * 64);
#pragma unroll
      for (int ks = 0; ks < 4; ++ks) wa[ks] = *(const bf16x8*)(gw + (kn * 4 + ks) * 512);
    }
    compute(1, wb);
    if (kt + 2 < nk) {
#pragma unroll
      for (int p = 0; p < 8; ++p) *(u32x4*)(sB + so + 32 * 72 * p) = rb[p];
    }
    __syncthreads();
  }
}

template <class F> DI void stage_bf16_w8(F f) {
  u16* sC = (u16*)smem;
  const int lane = TID() & 63, w = TID() >> 6, h = lane >> 5, c = lane & 31;
#pragma unroll
  for (int j = 0; j < 8; ++j)
#pragma unroll
    for (int g = 0; g < 4; ++g) {
      u32x2 pk; pk[0] = pk2(f(j, 4 * g), f(j, 4 * g + 1)); pk[1] = pk2(f(j, 4 * g + 2), f(j, 4 * g + 3));
      *(u32x2*)(sC + (j * 32 + c) * 136 + w * 32 + 8 * g + 4 * h) = pk;
    }
  __syncthreads();
}
DI void copy_out_bf16_256x128(u16* dst, size_t ld, int valid) {
  const u16* sC = (const u16*)smem;
  const int tid = TID();
#pragma unroll
  for (int q = 0; q < 16; ++q) {
    const int id = tid + 256 * q, row = id >> 4, cc = id & 15;
    if (cc * 8 < valid) *(u32x4*)(dst + (size_t)row * ld + cc * 8) = *(const u32x4*)(sC + row * 136 + cc * 8);
  }
}
template <class F> DI void stage_bf16_w8u(F f) {
  u16* sC = (u16*)smem;
  const int lane = TID() & 63, w = TID() >> 6, h = lane >> 5, c = lane & 31;
#pragma unroll
  for (int j = 0; j < 8; ++j)
#pragma unroll
    for (int g = 0; g < 2; ++g) {
      u32x2 pk; pk[0] = pk2(f(j, 4 * g), f(j, 4 * g + 1)); pk[1] = pk2(f(j, 4 * g + 2), f(j, 4 * g + 3));
      *(u32x2*)(sC + (j * 32 + c) * 72 + w * 16 + 8 * g + 4 * h) = pk;
    }
  __syncthreads();
}
DI void copy_out_bf16_256x64(u16* dst, size_t ld) {
  const u16* sC = (const u16*)smem;
  const int tid = TID();
#pragma unroll
  for (int q = 0; q < 8; ++q) {
    const int id = tid + 256 * q, row = id >> 3, cc = id & 7;
    *(u32x4*)(dst + (size_t)row * ld + cc * 8) = *(const u32x4*)(sC + row * 72 + cc * 8);
  }
}

DI void gemm_tile_wf2(const u16* Wfm, int K, int nrow0, const u16* Act, int ldact, f32x16 (&acc)[2]) {
  u16* sB = (u16*)smem;
  const int tid = TID(), lane = tid & 63, w = tid >> 6;
  const int lr = tid >> 3, lc = (tid & 7) * 8;
  const u16* gb = Act + (size_t)lr * ldact + lc;
  const size_t sb32 = (size_t)32 * ldact;
  const int kq = K >> 4;
  const u16* gw = Wfm + ((size_t)((nrow0 >> 5) + w) * kq) * 512 + lane * 8;
  const int so = lr * 72 + lc;
  const int nk = K >> 6;
  u32x4 rb[2];
  bf16x8 wa[4], wb[4];
#pragma unroll
  for (int p = 0; p < 2; ++p) rb[p] = *(const u32x4*)(gb + p * sb32);
#pragma unroll
  for (int ks = 0; ks < 4; ++ks) wa[ks] = *(const bf16x8*)(gw + ks * 512);
  __syncthreads();
#pragma unroll
  for (int p = 0; p < 2; ++p) *(u32x4*)(sB + so + 32 * 72 * p) = rb[p];
  __syncthreads();
  const int fo_b = (lane & 31) * 72 + (lane >> 5) * 8;
  auto compute = [&](int cur, bf16x8 (&wf)[4]) {
    const u16* pb = sB + cur * 64 * 72 + fo_b;
#pragma unroll
    for (int ks = 0; ks < 4; ++ks) {
#pragma unroll
      for (int j = 0; j < 2; ++j) acc[j] = MFMA(wf[ks], *(const bf16x8*)(pb + j * 32 * 72 + ks * 16), acc[j]);
    }
  };
  for (int kt = 0; kt < nk; kt += 2) {
    {
      const int k0 = (kt + 1) * 64;
#pragma unroll
      for (int p = 0; p < 2; ++p) rb[p] = *(const u32x4*)(gb + p * sb32 + k0);
#pragma unroll
      for (int ks = 0; ks < 4; ++ks) wb[ks] = *(const bf16x8*)(gw + ((kt + 1) * 4 + ks) * 512);
    }
    compute(0, wa);
#pragma unroll
    for (int p = 0; p < 2; ++p) *(u32x4*)(sB + 64 * 72 + so + 32 * 72 * p) = rb[p];
    __syncthreads();
    {
      const int kn = (kt + 2 < nk) ? kt + 2 : nk - 1;
#pragma unroll
      for (int p = 0; p < 2; ++p) rb[p] = *(const u32x4*)(gb + p * sb32 + kn * 64);
#pragma unroll
      for (int ks = 0; ks < 4; ++ks) wa[ks] = *(const bf16x8*)(gw + (kn * 4 + ks) * 512);
    }
    compute(1, wb);
    if (kt + 2 < nk) {
#pragma unroll
      for (int p = 0; p < 2; ++p) *(u32x4*)(sB + so + 32 * 72 * p) = rb[p];
    }
    __syncthreads();
  }
}
template <class F> DI void stage_bf16_w4(F f) {
  u16* sC = (u16*)smem;
  const int lane = TID() & 63, w = TID() >> 6, h = lane >> 5, c = lane & 31;
#pragma unroll
  for (int j = 0; j < 4; ++j)
#pragma unroll
    for (int g = 0; g < 4; ++g) {
      u32x2 pk; pk[0] = pk2(f(j, 4 * g), f(j, 4 * g + 1)); pk[1] = pk2(f(j, 4 * g + 2), f(j, 4 * g + 3));
      *(u32x2*)(sC + (j * 32 + c) * 136 + w * 32 + 8 * g + 4 * h) = pk;
    }
  __syncthreads();
}

template <class F> DI void stage_bf16_w4u(F f) {
  u16* sC = (u16*)smem;
  const int lane = TID() & 63, w = TID() >> 6, h = lane >> 5, c = lane & 31;
#pragma unroll
  for (int j = 0; j < 4; ++j)
#pragma unroll
    for (int g = 0; g < 2; ++g) {
      u32x2 pk; pk[0] = pk2(f(j, 4 * g), f(j, 4 * g + 1)); pk[1] = pk2(f(j, 4 * g + 2), f(j, 4 * g + 3));
      *(u32x2*)(sC + (j * 32 + c) * 72 + w * 16 + 8 * g + 4 * h) = pk;
    }
  __syncthreads();
}
DI void stage_f32_w4(f32x16 (&acc)[4]) {
  float* sC = (float*)smem;
  const int lane = TID() & 63, w = TID() >> 6, h = lane >> 5, c = lane & 31;
#pragma unroll
  for (int j = 0; j < 4; ++j)
#pragma unroll
    for (int g = 0; g < 4; ++g) {
      f4 v; v[0] = acc[j][4 * g]; v[1] = acc[j][4 * g + 1]; v[2] = acc[j][4 * g + 2]; v[3] = acc[j][4 * g + 3];
      *(f4*)(sC + (j * 32 + c) * 132 + w * 32 + 8 * g + 4 * h) = v;
    }
  __syncthreads();
}
DI void zero_acc(f32x16 (&acc)[2][2]) {
#pragma unroll
  for (int i = 0; i < 2; ++i)
#pragma unroll
    for (int j = 0; j < 2; ++j)
#pragma unroll
      for (int r = 0; r < 16; ++r) acc[i][j][r] = 0.f;
}
template <class F> DI void epi(f32x16 (&acc)[2][2], F f) {
  const int lane = TID() & 63, w = TID() >> 6, wm = w >> 1, wn = w & 1, h = lane >> 5, c = lane & 31;
#pragma unroll
  for (int i = 0; i < 2; ++i)
#pragma unroll
    for (int j = 0; j < 2; ++j)
#pragma unroll
      for (int r = 0; r < 16; ++r) f(wm * 64 + i * 32 + crow(r, h), wn * 64 + j * 32 + c, acc[i][j][r]);
}

template <int W, class F> DI void stage_bf16(F f) {
  u16* sC = (u16*)smem;
  const int lane = TID() & 63, w = TID() >> 6, wm = w >> 1, wn = w & 1, h = lane >> 5, c = lane & 31;
#pragma unroll
  for (int i = 0; i < 2; ++i)
#pragma unroll
    for (int j = 0; j < (W == 128 ? 2 : 1); ++j)
#pragma unroll
      for (int r = 0; r < 16; ++r) sC[(wm * 64 + i * 32 + crow(r, h)) * (W + 8) + wn * (W / 2) + j * 32 + c] = f2bf(f(i, j, r));
  __syncthreads();
}
template <int W> DI void copy_out_bf16(u16* dst, size_t ld, int valid) {
  const u16* sC = (const u16*)smem;
  constexpr int CPR = W / 8;
  const int tid = TID();
#pragma unroll
  for (int q = 0; q < 128 * CPR / 256; ++q) {
    const int id = tid + 256 * q, row = id / CPR, cc = id % CPR;
    if (cc * 8 < valid) *(u32x4*)(dst + (size_t)row * ld + cc * 8) = *(const u32x4*)(sC + row * (W + 8) + cc * 8);
  }
}

template <class F> DI void stage_bf16_sw(F f) {
  u16* sC = (u16*)smem;
  const int lane = TID() & 63, w = TID() >> 6, wm = w >> 1, wn = w & 1, h = lane >> 5, c = lane & 31;
#pragma unroll
  for (int i = 0; i < 2; ++i)
#pragma unroll
    for (int j = 0; j < 2; ++j)
#pragma unroll
      for (int g = 0; g < 4; ++g) {
        u32x2 pk; pk[0] = pk2(f(i, j, 4 * g), f(i, j, 4 * g + 1)); pk[1] = pk2(f(i, j, 4 * g + 2), f(i, j, 4 * g + 3));
        *(u32x2*)(sC + (wn * 64 + j * 32 + c) * 136 + wm * 64 + i * 32 + 8 * g + 4 * h) = pk;
      }
  __syncthreads();
}
template <class F> DI void stage_bf16_sw64(F f) {
  u16* sC = (u16*)smem;
  const int lane = TID() & 63, w = TID() >> 6, wm = w >> 1, wn = w & 1, h = lane >> 5, c = lane & 31;
#pragma unroll
  for (int j = 0; j < 2; ++j)
#pragma unroll
    for (int g = 0; g < 4; ++g) {
      u32x2 pk; pk[0] = pk2(f(j, 4 * g), f(j, 4 * g + 1)); pk[1] = pk2(f(j, 4 * g + 2), f(j, 4 * g + 3));
      *(u32x2*)(sC + (wn * 64 + j * 32 + c) * 72 + wm * 32 + 8 * g + 4 * h) = pk;
    }
  __syncthreads();
}
DI void stage_f32(f32x16 (&acc)[2][2]) {
  float* sC = (float*)smem;
  const int lane = TID() & 63, w = TID() >> 6, wm = w >> 1, wn = w & 1, h = lane >> 5, c = lane & 31;
#pragma unroll
  for (int i = 0; i < 2; ++i)
#pragma unroll
    for (int j = 0; j < 2; ++j)
#pragma unroll
      for (int r = 0; r < 16; ++r) sC[(wm * 64 + i * 32 + crow(r, h)) * 132 + wn * 64 + j * 32 + c] = acc[i][j][r];
  __syncthreads();
}
DI int vblock() { const int nb = gridDim.x, b = BID(); return (nb & 7) ? b : (b & 7) * (nb >> 3) + (b >> 3); }
DI void decode_tile(int idx, int NT, int& mt, int& nt) { const int g = idx / (8 * NT); const int r = idx - g * 8 * NT; nt = r >> 3; mt = g * 8 + (r & 7); }


DI void group_sync(const Params& p, int& nbar) {
  if (!USE_GSYNC) return;
  __syncthreads();
  nbar += 1;
  if ((gridDim.x & 7) == 0 && TID() == 0) {
    u32* c = (u32*)(WSP(p) + WS_CTR) + 64 + 32 * (BID() & 7);
    const u32 target = (gridDim.x >> 3) * (u32)nbar;
    __hip_atomic_fetch_add(c, 1u, __ATOMIC_RELAXED, __HIP_MEMORY_SCOPE_AGENT);
    while (__hip_atomic_load(c, __ATOMIC_RELAXED, __HIP_MEMORY_SCOPE_AGENT) < target) __builtin_amdgcn_s_sleep(1);
  }
  __syncthreads();
}
#define TILE_LOOP(NT_TOTAL) \
  for (int rd_ = 0, idx = vblock(); rd_ < ((NT_TOTAL) + (int)gridDim.x - 1) / (int)gridDim.x; ++rd_, idx += gridDim.x)


#define XB_TMO      128
#define XB_XCNT(j)  (256  + 64 * (j))
#define XB_XSUB(j)  (1280 + 64 * (j))
#define XB_XGEN(j)  (2304 + 64 * (j))
#define XB_TOP      3328
#define XB_TOPGEN   3392
#define XCD_BAR_WORDS 3456
#define XB_SPIN_CAP (1u << 20)
#define LAS __attribute__((address_space(3)))
DI unsigned xb_ld(unsigned* p) { return __hip_atomic_load(p, __ATOMIC_RELAXED, __HIP_MEMORY_SCOPE_AGENT); }
DI unsigned xb_add(unsigned* p, unsigned v) { return __hip_atomic_fetch_add(p, v, __ATOMIC_RELAXED, __HIP_MEMORY_SCOPE_AGENT); }
DI unsigned xb_xcc_id() { return (unsigned)__builtin_amdgcn_s_getreg((3 << 11) | 20) & 0xFu; }
#define XB_SPIN(cond, bar) do { unsigned _sp = 0; while (cond) { __builtin_amdgcn_s_sleep(1); \
    if ((++_sp & 255u) == 0u) { if (xb_ld(&(bar)[XB_TMO])) break; if (_sp > XB_SPIN_CAP) { atomicAdd(&(bar)[XB_TMO], 1u); break; } } } } while (0)
__shared__ uint4 xb_words;
DI void xcd_barrier_complete(unsigned* bar, unsigned x, unsigned& nloc, unsigned& nx) {
  const unsigned G = gridDim.x;
  unsigned sum, cnt, mine, sp = 0u;
  for (;;) {
    sum = 0u; cnt = 0u; mine = 0u;
#pragma unroll
    for (unsigned j = 0; j < 16; ++j) { const unsigned c = xb_ld(&bar[XB_XCNT(j)]); sum += c; cnt += (c > 0u) ? 1u : 0u; mine = (j == x) ? c : mine; }
    if (sum == G) break;
    __builtin_amdgcn_s_sleep(1);
    if ((++sp & 255u) == 0u) { if (xb_ld(&bar[XB_TMO])) break; if (sp > XB_SPIN_CAP) { atomicAdd(&bar[XB_TMO], 1u); break; } }
  }
  nloc = mine > 0u ? mine : 1u; nx = cnt > 0u ? cnt : 1u;
}
DI void gsync(const Params& p) {
  asm volatile("s_waitcnt vmcnt(0)" ::: "memory");
  __syncthreads();
  if (threadIdx.x == 0) {
    unsigned* bar = (unsigned*)(WSP(p) + WS_BAR);
    volatile LAS unsigned* st = (volatile LAS unsigned*)&xb_words;
    const unsigned x = xb_xcc_id();
    __builtin_amdgcn_s_waitcnt(0);
    unsigned nloc = st[0], nx = st[1];
    if (nloc == 0u) { xcd_barrier_complete(bar, x, nloc, nx); st[0] = nloc; st[1] = nx; }
    const unsigned old = xb_add(&bar[XB_XSUB(x)], 1u);
    const unsigned gen = old / nloc;
    if (old + 1u == (gen + 1u) * nloc) {
      __builtin_amdgcn_fence(__ATOMIC_RELEASE, "agent");
      asm volatile("s_waitcnt vmcnt(0)" ::: "memory");
      const unsigned og = xb_add(&bar[XB_TOP], 1u);
      const unsigned tg = og / nx;
      if (og + 1u == (tg + 1u) * nx) xb_add(&bar[XB_TOPGEN], 1u);
      else XB_SPIN(xb_ld(&bar[XB_TOPGEN]) == tg, bar);
      __builtin_amdgcn_fence(__ATOMIC_ACQUIRE, "agent");
      xb_add(&bar[XB_XGEN(x)], 1u);
      asm volatile("s_waitcnt vmcnt(0)" ::: "memory");
    } else {
      XB_SPIN(xb_ld(&bar[XB_XGEN(x)]) == gen, bar);
      __builtin_amdgcn_fence(__ATOMIC_ACQUIRE, "agent");
      asm volatile("s_waitcnt vmcnt(0)" ::: "memory");
    }
  }
  __syncthreads();
}

DI void conv_matrix(const float* src, int K, int ldn, int N, u16* dst, const float* scale, int mode, int off, int rot) {
  float* sm = (float*)smem;
  const int tid = TID(), nb = gridDim.x;
  const int nkt = K >> 6, nnt = (N + 63) >> 6;
  int b0 = BID() - rot; if (b0 < 0) b0 += nb;
  for (int it = b0; it < nkt * nnt; it += nb) {
    const int kt = it % nkt, nt = it / nkt, k0 = kt * 64, n0 = nt * 64;
    __syncthreads();
    const int r = tid >> 4, c4 = (tid & 15) * 4;
#pragma unroll
    for (int p = 0; p < 4; ++p) {
      const int k = r + 16 * p;
      f4 v = {0.f, 0.f, 0.f, 0.f};
      if (n0 + c4 < N) v = *(const f4*)(src + (size_t)(k0 + k) * ldn + n0 + c4);
      if (scale) { const float s = scale[k0 + k]; v *= s; }
      sm[k * 65 + c4 + 0] = v[0]; sm[k * 65 + c4 + 1] = v[1]; sm[k * 65 + c4 + 2] = v[2]; sm[k * 65 + c4 + 3] = v[3];
    }
    __syncthreads();
    const int n = tid & 63, kc = tid >> 6;
    if (n0 + n < N) {
      const int ng = n0 + n;
      const int row = (mode & 4) ? ((ng >> 4) * 32 + (ng & 15) + off) : (mode & 1) ? ((ng >> 5) * 64 + (ng & 31) + off) : ng;
#pragma unroll
      for (int q = 0; q < 2; ++q) {
        const int c = kc + 4 * q;
        const float* s = sm + (8 * c) * 65 + n;
        u32x4 o;
        o[0] = pk2(s[0], s[65]); o[1] = pk2(s[2 * 65], s[3 * 65]); o[2] = pk2(s[4 * 65], s[5 * 65]); o[3] = pk2(s[6 * 65], s[7 * 65]);
        if (mode & 2) *(u32x4*)(dst + ((size_t)(row >> 5) * (K >> 4) + ((k0 + 8 * c) >> 4)) * 512 + (((k0 + 8 * c) >> 3) & 1) * 256 + (row & 31) * 8) = o;
        else *(u32x4*)(dst + (size_t)row * K + k0 + 8 * c) = o;
      }
    }
  }
}

DI void norm_phase(const Params& p, int l, int which) {
  const float* X = OUTP(p);
  u16* H = (u16*)(WSP(p) + WS_H);
  const float* nw = INP(p, which ? I_N2 : I_N1) + l * 1024;
  const float* MOD = (const float*)(WSP(p) + WS_MOD) + (size_t)l * 5 * 6144;
  const int lane = TID() & 63, gw = BID() * 4 + (TID() >> 6), nw_ = gridDim.x * 4;
  for (int t = gw; t < T; t += nw_) {
    const int cb = t < TC ? 0 : 1 + ((t - TC) >> 12);
    const float* sh = MOD + cb * 6144 + (which ? 3 : 0) * 1024;
    const float* sc = sh + 1024;
    const f4* xr = (const f4*)(X + (size_t)t * 1024) + lane;
    f4 v[4]; float s = 0.f;
#pragma unroll
    for (int j = 0; j < 4; ++j) { v[j] = xr[64 * j]; s += v[j][0] * v[j][0] + v[j][1] * v[j][1] + v[j][2] * v[j][2] + v[j][3] * v[j][3]; }
    const float rstd = rsqrtf(wave_sum(s) * (1.f / 1024.f) + EPS);
#pragma unroll
    for (int j = 0; j < 4; ++j) {
      const int c = 4 * lane + 256 * j;
      const f4 wv = *(const f4*)(nw + c), scv = *(const f4*)(sc + c), shv = *(const f4*)(sh + c);
      float o[4];
#pragma unroll
      for (int e = 0; e < 4; ++e) o[e] = v[j][e] * rstd * wv[e] * (1.f + scv[e]) + shv[e];
      u32x2 pk; pk[0] = pk2(o[0], o[1]); pk[1] = pk2(o[2], o[3]);
      *(u32x2*)(H + (size_t)t * 1024 + c) = pk;
    }
  }
}

DI void pre_phase(const Params& p) {
  const int tid = TID(), nb = gridDim.x;
  if (BID() == 0) { for (int i = tid; i < 1024; i += 256) ((u32*)(WSP(p) + WS_CTR))[i] = 0u; }
  {
    f4* X4 = (f4*)OUTP(p);
    const f4* xp = (const f4*)INP(p, I_XP); const f4* xs = (const f4*)INP(p, I_XS);
    const int n4 = T * 256, nc4 = TC * 256;
    for (int i = BID() * 256 + tid; i < n4; i += nb * 256) X4[i] = (i < nc4) ? xp[i] : xs[i - nc4];
  }
  float* sm = (float*)smem;
  float* MOD = (float*)(WSP(p) + WS_MOD);
  __syncthreads();
  for (int i = tid; i < 5 * 1024; i += 256) {
    const int cb = i >> 10, k = i & 1023;
    const float cv = cb == 0 ? INP(p, I_CCTX)[k] : INP(p, I_C)[(cb - 1) * 1024 + k];
    sm[i] = silu_f(cv);
  }
  __syncthreads();
  float* red = sm + 5 * 1024;
  for (int it = BID(); it < NLAYER * 48; it += nb) {
    const int l = it / 48, n0 = (it % 48) * 128;
    const int c4 = (tid & 31) * 4, kg = tid >> 5;
    float a[5][4];
#pragma unroll
    for (int cb = 0; cb < 5; ++cb)
#pragma unroll
      for (int e = 0; e < 4; ++e) a[cb][e] = 0.f;
    const float* wsrc = INP(p, I_WADA) + (size_t)l * 1024 * 6144 + n0 + c4;
    for (int k = kg * 128; k < kg * 128 + 128; ++k) {
      const f4 wv = *(const f4*)(wsrc + (size_t)k * 6144);
#pragma unroll
      for (int cb = 0; cb < 5; ++cb) {
        const float s = sm[cb * 1024 + k];
#pragma unroll
        for (int e = 0; e < 4; ++e) a[cb][e] += s * wv[e];
      }
    }
    __syncthreads();
#pragma unroll
    for (int cb = 0; cb < 5; ++cb)
#pragma unroll
      for (int e = 0; e < 4; ++e) red[(kg * 5 + cb) * 128 + c4 + e] = a[cb][e];
    __syncthreads();
    for (int o = tid; o < 5 * 128; o += 256) {
      const int cb = o >> 7, n = o & 127;
      float s = INP(p, I_BADA)[l * 6144 + n0 + n];
#pragma unroll
      for (int g = 0; g < 8; ++g) s += red[(g * 5 + cb) * 128 + n];
      MOD[((size_t)l * 5 + cb) * 6144 + n0 + n] = s;
    }
  }
}

DI void l1_phase(const Params& p, int l) {
  u16* W = (u16*)(WSP(p) + WS_W);
  conv_matrix(INP(p, I_WIN) + (size_t)l * 1024 * INC, 1024, INC, NPROJ, W + W_IN, nullptr, 2, 0, 0);
  conv_matrix(INP(p, I_WIN) + (size_t)l * 1024 * INC + NPROJ, 1024, INC, 3072, W + W_GATE, nullptr, 2, 0, 300);
  conv_matrix(INP(p, I_F1) + (size_t)l * 1024 * FF, 1024, FF, FF, W + W_F13, nullptr, 6, 0, 64);
  conv_matrix(INP(p, I_F3) + (size_t)l * 1024 * FF, 1024, FF, FF, W + W_F13, nullptr, 6, 16, 128);
  conv_matrix(INP(p, I_F2) + (size_t)l * FF * 1024, FF, 1024, 1024, W + W_F2, nullptr, 2, 0, 192);
  conv_matrix(INP(p, I_WAO) + (size_t)l * 512 * 1024, 512, 1024, 1024, W + W_A, nullptr, 0, 0, 32);
  conv_matrix(INP(p, I_WBO) + (size_t)l * 1024 * 1024, 1024, 1024, 1024, W + W_B, INP(p, I_SNW) + l * 1024, 0, 0, 96);
  conv_matrix(INP(p, I_WUQ) + (size_t)l * 256 * 768, 256, 768, 768, W + W_UQ, INP(p, I_QNW) + l * 256, 0, 0, 160);
  conv_matrix(INP(p, I_WUKV) + (size_t)l * 256 * 1024, 256, 1024, 1024, W + W_UKV, nullptr, 0, 0, 224);
  conv_matrix(INP(p, I_WCO) + (size_t)l * 512 * 1024, 512, 1024, 1024, W + W_C, nullptr, 0, 0, 16);
  conv_matrix(INP(p, I_WO) + (size_t)l * 1024 * 1024, 1024, 1024, 1024, W + W_O, nullptr, 2, 0, 80);
  norm_phase(p, l, 0);
}

DI void l2_phase(const Params& p, int l, int& nbar) {
  const u16* H = (const u16*)(WSP(p) + WS_H);
  const u16* W = (const u16*)(WSP(p) + WS_W) + W_IN;
  u16* ACT = (u16*)(WSP(p) + WS_ACT);
  float* DT = (float*)(WSP(p) + WS_DT);
  constexpr int NT = 37, MT = 80;
  TILE_LOOP(MT * NT) {
    group_sync(p, nbar);
    if (idx >= MT * NT) continue;
    int mt, nt; decode_tile(idx, NT, mt, nt);
    f32x16 acc[8];
#pragma unroll
    for (int j = 0; j < 8; ++j)
#pragma unroll
      for (int r = 0; r < 16; ++r) acc[j][r] = 0.f;
    gemm_tile_wf8(W, 1024, nt * 128, H + (size_t)mt * 256 * 1024, 1024, acc);
    const int m0 = mt * 256, n0 = nt * 128;
    if (nt == 32 || (nt == 36 && mt < 16)) {
      const int lane = TID() & 63, w = TID() >> 6, h = lane >> 5, c = lane & 31;
#pragma unroll
      for (int j = 0; j < 8; ++j)
#pragma unroll
        for (int r = 0; r < 16; ++r) {
          const int t = m0 + j * 32 + c, cc = n0 + w * 32 + crow(r, h);
          const float v = acc[j][r];
          if (cc >= C_DT && cc < C_DT + 16) DT[t * 16 + cc - C_DT] = v;
          if (cc >= C_KR && cc < NPROJ && t < TC) OUTP(p)[O_KR + ((size_t)((t >> 8) * 4 + l) * 256 + (t & 255)) * 32 + (cc - C_KR)] = v;
        }
    }
    stage_bf16_w8([&](int j, int r) { return acc[j][r]; });
    copy_out_bf16_256x128(ACT + (size_t)m0 * LDA + n0, LDA, NPROJ - n0);
  }
}

DI void unpack8(const u32x4 v, float (&f)[8]) {
#pragma unroll
  for (int i = 0; i < 4; ++i) { f[2 * i] = bflo(v[i]); f[2 * i + 1] = bfhi(v[i]); }
}
DI u32x4 pack8(const float (&f)[8]) { u32x4 o; o[0] = pk2(f[0], f[1]); o[1] = pk2(f[2], f[3]); o[2] = pk2(f[4], f[5]); o[3] = pk2(f[6], f[7]); return o; }

DI void l3_phase(const Params& p, int l) {
  const u16* ACT = (const u16*)(WSP(p) + WS_ACT);
  const int tid = TID(), nb = gridDim.x;
  {
    u16* YA = (u16*)(WSP(p) + WS_YA);
    const float* cw = INP(p, I_ACW) + l * 3 * 512;
    for (int it = BID() * 256 + tid; it < T * 64; it += nb * 256) {
      const int t = it >> 6, c8 = (it & 63) * 8;
      const int pos = t < TC ? (t & 255) : ((t - TC) & 4095);
      const int L = t < TC ? 256 : 4096;
      const u16* row = ACT + (size_t)t * LDA;
      float u0[8], u1[8], u2[8], ab[8], a1[8], a2[8];
      unpack8(*(const u32x4*)(row + C_AX + c8), a1); unpack8(*(const u32x4*)(row + C_AC + c8), a2);
#pragma unroll
      for (int e = 0; e < 8; ++e) u1[e] = a1[e] * a2[e];
      if (pos > 0) {
        unpack8(*(const u32x4*)(row - LDA + C_AX + c8), a1); unpack8(*(const u32x4*)(row - LDA + C_AC + c8), a2);
#pragma unroll
        for (int e = 0; e < 8; ++e) u0[e] = a1[e] * a2[e];
      } else {
#pragma unroll
        for (int e = 0; e < 8; ++e) u0[e] = 0.f;
      }
      if (pos < L - 1) {
        unpack8(*(const u32x4*)(row + LDA + C_AX + c8), a1); unpack8(*(const u32x4*)(row + LDA + C_AC + c8), a2);
#pragma unroll
        for (int e = 0; e < 8; ++e) u2[e] = a1[e] * a2[e];
      } else {
#pragma unroll
        for (int e = 0; e < 8; ++e) u2[e] = 0.f;
      }
      unpack8(*(const u32x4*)(row + C_AB + c8), ab);
      float o[8];
#pragma unroll
      for (int e = 0; e < 8; ++e) o[e] = ab[e] * (cw[c8 + e] * u0[e] + cw[512 + c8 + e] * u1[e] + cw[1024 + c8 + e] * u2[e]);
      *(u32x4*)(YA + (size_t)t * 512 + c8) = pack8(o);
    }
  }
  {
    u16* XT = (u16*)(WSP(p) + WS_XT); u16* BCP = (u16*)(WSP(p) + WS_BCP); u16* BT = (u16*)(WSP(p) + WS_BT);
    const float* cw = INP(p, I_SCW) + l * 3 * 1536;
    const float* cbias = INP(p, I_SCB) + l * 1536;
    u16* sr = (u16*)smem;
    for (int it = BID(); it < 160 * 24; it += nb) {
      const int chunk = it / 24, cbk = it % 24, ch0 = cbk * 64, t0 = chunk * 128;
      const bool first = chunk < 32 ? ((chunk & 1) == 0) : (((chunk - 32) & 31) == 0);
      const bool last = chunk < 32 ? ((chunk & 1) == 1) : (((chunk - 32) & 31) == 31);
      __syncthreads();
      for (int id = tid; id < 130 * 8; id += 256) {
        const int r = id >> 3, c8 = (id & 7) * 8;
        u32x4 v = {0u, 0u, 0u, 0u};
        const bool ok = !((r == 0 && first) || (r == 129 && last));
        if (ok) v = *(const u32x4*)(ACT + (size_t)(t0 - 1 + r) * LDA + C_XBC + ch0 + c8);
        *(u32x4*)(sr + r * 72 + c8) = v;
      }
      __syncthreads();
      if (cbk >= 16) {
        const int c8 = (tid & 7) * 8;
        float w0[8], w1[8], w2[8], bb[8];
#pragma unroll
        for (int e = 0; e < 8; ++e) { w0[e] = cw[ch0 + c8 + e]; w1[e] = cw[1536 + ch0 + c8 + e]; w2[e] = cw[3072 + ch0 + c8 + e]; bb[e] = cbias[ch0 + c8 + e]; }
#pragma unroll
        for (int q = 0; q < 4; ++q) {
          const int r = (tid >> 3) + 32 * q;
          float x0[8], x1[8], x2[8], o[8];
          unpack8(*(const u32x4*)(sr + r * 72 + c8), x0); unpack8(*(const u32x4*)(sr + (r + 1) * 72 + c8), x1); unpack8(*(const u32x4*)(sr + (r + 2) * 72 + c8), x2);
#pragma unroll
          for (int e = 0; e < 8; ++e) o[e] = silu_f(w0[e] * x0[e] + w1[e] * x1[e] + w2[e] * x2[e] + bb[e]);
          *(u32x4*)(BCP + (size_t)(t0 + r) * 512 + (ch0 - 1024) + c8) = pack8(o);
        }
      }
      if (cbk < 20) {
        const int ch = tid & 63, jg0 = tid >> 6;
        const float w0 = cw[ch0 + ch], w1 = cw[1536 + ch0 + ch], w2 = cw[3072 + ch0 + ch], bb = cbias[ch0 + ch];
        u16* dst = cbk < 16 ? XT + ((size_t)chunk * 1024 + ch0 + ch) * 128 : BT + ((size_t)chunk * 256 + (ch0 - 1024) + ch) * 128;
#pragma unroll
        for (int q = 0; q < 4; ++q) {
          const int g = jg0 + 4 * q;
          float xv[10], o[8];
#pragma unroll
          for (int e = 0; e < 10; ++e) xv[e] = bf2f(sr[(8 * g + e) * 72 + ch]);
#pragma unroll
          for (int e = 0; e < 8; ++e) o[e] = silu_f(w0 * xv[e] + w1 * xv[e + 1] + w2 * xv[e + 2] + bb);
          *(u32x4*)(dst + 8 * g) = pack8(o);
        }
      }
    }
  }
  {
    u16* CKVA = (u16*)(WSP(p) + WS_CKVA); u16* KRA = (u16*)(WSP(p) + WS_KR);
    float* RQ = (float*)(WSP(p) + WS_RQ);
    const float* kvw = INP(p, I_KVNW) + l * 256;
    const int lane = tid & 63, gw = BID() * 4 + (tid >> 6), nwv = nb * 4;
    for (int it = gw; it < T + 2048; it += nwv) {
      if (it < T) {
        const int t = it;
        const u16* row = ACT + (size_t)t * LDA;
        const u32x2 kv = *(const u32x2*)(row + C_CKV + 4 * lane);
        const u32x2 qv = *(const u32x2*)(row + C_CQ + 4 * lane);
        float k4[4] = {bflo(kv[0]), bfhi(kv[0]), bflo(kv[1]), bfhi(kv[1])};
        float q4[4] = {bflo(qv[0]), bfhi(qv[0]), bflo(qv[1]), bfhi(qv[1])};
        const float ssk = wave_sum(k4[0] * k4[0] + k4[1] * k4[1] + k4[2] * k4[2] + k4[3] * k4[3]);
        const float ssq = wave_sum(q4[0] * q4[0] + q4[1] * q4[1] + q4[2] * q4[2] + q4[3] * q4[3]);
        const float rk = rsqrtf(ssk * (1.f / 256.f) + EPS);
        if (lane == 0) RQ[t] = rsqrtf(ssq * (1.f / 256.f) + EPS);
        const f4 wv = *(const f4*)(kvw + 4 * lane);
        f4 o; o[0] = k4[0] * rk * wv[0]; o[1] = k4[1] * rk * wv[1]; o[2] = k4[2] * rk * wv[2]; o[3] = k4[3] * rk * wv[3];
        int krow, pos;
        if (t < TC) { krow = KROW_CTX + t; pos = t & 255; *(f4*)(OUTP(p) + O_CKV + ((size_t)((t >> 8) * 4 + l) * 256 + pos) * 256 + 4 * lane) = o; }
        else { const int b = (t - TC) >> 12; pos = (t - TC) & 4095; krow = b * LKL + 512 + pos; }
        u32x2 pk; pk[0] = pk2(o[0], o[1]); pk[1] = pk2(o[2], o[3]);
        *(u32x2*)(CKVA + (size_t)krow * 256 + 4 * lane) = pk;
        if (lane < 16) {
          float x1 = bf2f(row[C_KR + lane]), x2 = bf2f(row[C_KR + 16 + lane]);
          if (t >= TC) {
            const float pp = (lane < 8) ? (float)(pos >> 6) : (float)(pos & 63);
            const float inv = exp2f(-(float)(lane & 7) * (13.287712379549449f / 8.f));
            const float ang = pp * inv;
            const float cs = cosf(ang), sn = sinf(ang);
            const float y1 = x1 * cs - x2 * sn, y2 = x1 * sn + x2 * cs;
            x1 = y1; x2 = y2;
          }
          KRA[(size_t)krow * 32 + lane] = f2bf(x1); KRA[(size_t)krow * 32 + 16 + lane] = f2bf(x2);
        }
      } else {
        const int j = it - T, b = j >> 9, r = j & 511;
        const int krow = b * LKL + r;
        const f4 v = *(const f4*)(INP(p, I_CCKV) + ((size_t)(b * 4 + l) * 512 + r) * 256 + 4 * lane);
        u32x2 pk; pk[0] = pk2(v[0], v[1]); pk[1] = pk2(v[2], v[3]);
        *(u32x2*)(CKVA + (size_t)krow * 256 + 4 * lane) = pk;
        if (lane < 32) KRA[(size_t)krow * 32 + lane] = f2bf(INP(p, I_CKR)[((size_t)(b * 4 + l) * 512 + r) * 32 + lane]);
      }
    }
  }
}

DI void l3d_phase(const Params& p, int l) {
  const float* DT = (const float*)(WSP(p) + WS_DT);
  float* CUMS = (float*)(WSP(p) + WS_CUMS);
  const int tid = TID(), lane = tid & 63, gw = BID() * 4 + (tid >> 6), nwv = gridDim.x * 4;
  for (int it = gw; it < 160 * 32; it += nwv) {
    const int chunk = it >> 5, dir = (it >> 4) & 1, head = it & 15, t0 = chunk * 128;
    const float a = -__expf(INP(p, I_ALOG)[(l * 2 + dir) * 16 + head]);
    const float dtb = INP(p, I_DTB)[(l * 2 + dir) * 16 + head];
    const int k0 = 2 * lane, k1 = 2 * lane + 1;
    const int tk0 = dir ? 127 - k0 : k0, tk1 = dir ? 127 - k1 : k1;
    const float x0 = DT[(t0 + tk0) * 16 + head] + dtb, x1 = DT[(t0 + tk1) * 16 + head] + dtb;
    const float d0 = x0 > 20.f ? x0 : log1pf(__expf(x0)), d1 = x1 > 20.f ? x1 : log1pf(__expf(x1));
    const float v0 = d0 * a, v1 = d1 * a;
    float s = v0 + v1;
#pragma unroll
    for (int o = 1; o < 64; o <<= 1) { const float n = __shfl_up(s, o); if (lane >= o) s += n; }
    const float total = __shfl(s, 63);
    const float c1 = s, c0 = s - v1;
    float* cs = CUMS + (size_t)it * 768;
    const float cref = __shfl(c1, (lane & ~7) | 7);
    cs[tk0] = c0; cs[tk1] = c1; cs[128 + tk0] = __expf(cref - c0) * d0; cs[128 + tk1] = __expf(cref - c1) * d1;
    cs[640 + tk0] = d0; cs[640 + tk1] = d1;
    {
      const float cfirst = __shfl(c0, lane & ~7);
      if ((lane & 7) == 7) { cs[520 + (tk1 >> 4)] = c1; cs[528 + (tk1 >> 4)] = cfirst - c1; }
    }
    cs[256 + tk0] = __expf(total - c0) * d0; cs[256 + tk1] = __expf(total - c1) * d1;
    cs[384 + tk0] = __expf(c0); cs[384 + tk1] = __expf(c1);
    if (lane == 0) cs[512] = __expf(total);
  }
}

DI void l4_phase(const Params& p, int l, int& nbar) {
  constexpr int NQ = 160 * 6, NKV = 176 * 8, NCB = 320;
  TILE_LOOP(NQ + NKV + NCB) {
    group_sync(p, nbar);
    if (idx >= NQ + NKV + NCB) continue;
    const u16* W = (const u16*)(WSP(p) + WS_W);
    const u16* ACT = (const u16*)(WSP(p) + WS_ACT);
    f32x16 acc[2][2]; zero_acc(acc);
    if (idx < NQ) {
      int mt, nt; decode_tile(idx, 6, mt, nt);
      gemm_tile(W + W_UQ + (size_t)nt * 128 * 256, 256, ACT + (size_t)mt * 128 * LDA + C_CQ, LDA, 256, acc);
      const float* RQ = (const float*)(WSP(p) + WS_RQ);
      u16* Q = (u16*)(WSP(p) + WS_Q);
      const int m0 = mt * 128, n0 = nt * 128;
      {
        const int lane = TID() & 63, w = TID() >> 6, wn = w & 1, c = lane & 31;
        const float rq0 = RQ[m0 + wn * 64 + c], rq1 = RQ[m0 + wn * 64 + 32 + c];
        stage_bf16_sw([&](int i, int j, int r) { return acc[i][j][r] * (j ? rq1 : rq0); });
        copy_out_bf16<128>(Q + (size_t)m0 * 768 + n0, 768, 128);
      }
    } else if (idx < NQ + NKV) {
      int mt, nt; decode_tile(idx - NQ, 8, mt, nt);
      gemm_tile((const u16*)(WSP(p) + WS_CKVA) + (size_t)mt * 128 * 256, 256, W + W_UKV + (size_t)nt * 128 * 256, 256, 256, acc);
      u16* KN = (u16*)(WSP(p) + WS_KN); u16* VT = (u16*)(WSP(p) + WS_VT);
      const int lane = TID() & 63, w = TID() >> 6, wm = w >> 1, wn = w & 1, h = lane >> 5, c = lane & 31;
      const int kr0 = mt * 128;
      size_t vbase; int Lk, key0;
      if (kr0 < KROW_CTX) { const int b = kr0 / LKL; key0 = kr0 - b * LKL; Lk = LKL; vbase = (size_t)b * 512 * LKL; }
      else { const int s = (kr0 - KROW_CTX) >> 8; key0 = (kr0 - KROW_CTX) & 255; Lk = 256; vbase = (size_t)4 * 512 * LKL + (size_t)s * 512 * 256; }
#pragma unroll
      for (int i = 0; i < 2; ++i)
#pragma unroll
        for (int j = 0; j < 2; ++j) {
          const int d = j * 32 + c;
          if (wn == 0) {
#pragma unroll
            for (int r = 0; r < 16; ++r) KN[(size_t)(kr0 + wm * 64 + i * 32 + crow(r, h)) * 512 + nt * 64 + d] = f2bf(acc[i][j][r]);
          } else {
#pragma unroll
            for (int g = 0; g < 4; ++g) {
              const int key = key0 + wm * 64 + i * 32 + 8 * g + 4 * h;
              u32x2 pk; pk[0] = pk2(acc[i][j][4 * g], acc[i][j][4 * g + 1]); pk[1] = pk2(acc[i][j][4 * g + 2], acc[i][j][4 * g + 3]);
              *(u32x2*)(VT + vbase + (size_t)(nt * 64 + d) * Lk + key) = pk;
            }
          }
        }
    } else {
      const int ci = idx - NQ - NKV, chunk = ci >> 1, g = ci & 1;
      const u16* BCP = (const u16*)(WSP(p) + WS_BCP) + (size_t)chunk * 128 * 512;
      gemm_tile(BCP + 256 + g * 128, 512, BCP + g * 128, 512, 128, acc);
      u16* CB = (u16*)(WSP(p) + WS_CB) + (size_t)ci * 128 * 128;
      epi(acc, [&](int m, int n, float v) { CB[m * 128 + n] = f2bf(v); });
    }
  }
}

DI void ssd_unit(const Params& p, int l, int unit) {
  const int tid = TID(), lane = tid & 63, w = __builtin_amdgcn_readfirstlane(tid >> 6), h = lane >> 5, c = lane & 31;
  int dir, head, nc, chunk0, sidx; bool lat;
  if (unit < 128) { lat = true; sidx = unit >> 5; dir = (unit >> 4) & 1; head = unit & 15; nc = 32; chunk0 = 32 + sidx * 32; }
  else { const int u = unit - 128; lat = false; sidx = u >> 5; dir = (u >> 4) & 1; head = u & 15; nc = 2; chunk0 = sidx * 2; }
  const int g = head >> 3;
  const float Dk = INP(p, I_SD)[(l * 2 + dir) * 16 + head];
  u16* sXT = (u16*)smem; u16* sXS = sXT + 64 * 136; u16* sHS = sXS + 64 * 136;
  float* cum = (float*)(sHS + 64 * 136); float* dtv = cum + 128; float* ecum = dtv + 128; float* dtr = ecum + 128;
  const u16* XT = (const u16*)(WSP(p) + WS_XT); const u16* BCP = (const u16*)(WSP(p) + WS_BCP); const u16* BT = (const u16*)(WSP(p) + WS_BT);
  const u16* CB = (const u16*)(WSP(p) + WS_CB); const float* CUMS = (const float*)(WSP(p) + WS_CUMS);
  u16* Y = (u16*)(WSP(p) + WS_ACT) + (dir ? C_YB : C_YF);
  f32x16 S[2];
  if (lat) {
    const float* st = INP(p, dir ? I_STB : I_STF) + ((size_t)((sidx * 4 + l) * 16 + head) * 64) * 128;
#pragma unroll
    for (int mt = 0; mt < 2; ++mt)
#pragma unroll
      for (int r = 0; r < 16; ++r) S[mt][r] = st[(size_t)(32 * mt + crow(r, h)) * 128 + 32 * w + c];
  } else {
#pragma unroll
    for (int mt = 0; mt < 2; ++mt)
#pragma unroll
      for (int r = 0; r < 16; ++r) S[mt][r] = 0.f;
  }
  __syncthreads();
#pragma unroll
  for (int mt = 0; mt < 2; ++mt)
#pragma unroll
    for (int r = 0; r < 16; ++r) sHS[(32 * mt + crow(r, h)) * 136 + 32 * w + c] = f2bf(S[mt][r]);
  const int i = 32 * w + c;
  const int ks_lo = dir ? 2 * w : 0, ks_hi = dir ? 8 : 2 * w + 2;
  const int pr0 = tid >> 4, j0 = (tid & 15) * 8;

  for (int step = 0; step < nc; ++step) {
    const int chunk = chunk0 + (dir ? nc - 1 - step : step);
    const int t0 = chunk * 128;
    const float* cs = CUMS + ((size_t)(chunk * 2 + dir) * 16 + head) * 768;
    u32x4 xr[4];
    const u16* xsrc = XT + ((size_t)chunk * 1024 + head * 64) * 128;
#pragma unroll
    for (int q = 0; q < 4; ++q) xr[q] = *(const u32x4*)(xsrc + (size_t)(pr0 + 16 * q) * 128 + j0);
    const f4 e1lo = *(const f4*)(cs + 256 + j0), e1hi = *(const f4*)(cs + 256 + j0 + 4);
    float t_cum = 0.f, t_dt = 0.f, t_ec = 0.f;
    float t_dr = 0.f;
    if (tid < 128) { t_cum = cs[tid]; t_dt = cs[128 + tid]; t_ec = cs[384 + tid]; t_dr = cs[640 + tid]; }
    const float dec = cs[512];
    float cref8[8], span8[8];
#pragma unroll
    for (int ks = 0; ks < 8; ++ks) { cref8[ks] = cs[520 + ks]; span8[ks] = cs[528 + ks]; }
    const u16* crowp = BCP + (size_t)(t0 + i) * 512 + 256 + g * 128 + 8 * h;
    const u16* cbrow = CB + ((size_t)(chunk * 2 + g) * 128 + i) * 128 + 8 * h;
    const u16* btrow = BT + ((size_t)chunk * 256 + g * 128 + 32 * w + c) * 128 + 8 * h;
    bf16x8 cf[8], btf[8]; u32x4 cbf[8];
#pragma unroll
    for (int ks = 0; ks < 8; ++ks) cf[ks] = *(const bf16x8*)(crowp + ks * 16);
#pragma unroll
    for (int ks = 0; ks < 8; ++ks) { u32x4 z = {0u, 0u, 0u, 0u}; cbf[ks] = (ks >= ks_lo && ks < ks_hi) ? *(const u32x4*)(cbrow + ks * 16) : z; }
#pragma unroll
    for (int ks = 0; ks < 8; ++ks) btf[ks] = *(const bf16x8*)(btrow + ks * 16);
    __builtin_amdgcn_sched_barrier(0);
    if (tid < 128) { cum[tid] = t_cum; dtv[tid] = t_dt; ecum[tid] = t_ec; dtr[tid] = t_dr; }
    {
      const float e1v[8] = {e1lo[0], e1lo[1], e1lo[2], e1lo[3], e1hi[0], e1hi[1], e1hi[2], e1hi[3]};
#pragma unroll
      for (int q = 0; q < 4; ++q) {
        const int pr = pr0 + 16 * q;
        *(u32x4*)(sXT + pr * 136 + j0) = xr[q];
        float f[8]; unpack8(xr[q], f);
#pragma unroll
        for (int e = 0; e < 8; ++e) f[e] *= e1v[e];
        *(u32x4*)(sXS + pr * 136 + j0) = pack8(f);
      }
    }
    __syncthreads();
    f32x16 Y1[2];
#pragma unroll
    for (int nt = 0; nt < 2; ++nt)
#pragma unroll
      for (int r = 0; r < 16; ++r) Y1[nt][r] = 0.f;
#pragma unroll
    for (int ks = 0; ks < 8; ++ks) {
#pragma unroll
      for (int nt = 0; nt < 2; ++nt) {
        const bf16x8 bfv = *(const bf16x8*)(sHS + (32 * nt + c) * 136 + ks * 16 + 8 * h);
        Y1[nt] = MFMA(cf[ks], bfv, Y1[nt]);
      }
    }
#pragma unroll
    for (int nt = 0; nt < 2; ++nt)
#pragma unroll
      for (int r = 0; r < 16; ++r) Y1[nt][r] *= ecum[32 * w + crow(r, h)];
    const float ci_ = cum[i];
#pragma unroll
    for (int ks = 0; ks < 8; ++ks) {
      if (ks >= ks_lo && ks < ks_hi) {
        float f[8]; unpack8(cbf[ks], f);
        if (span8[ks] <= 40.f) {
          const float rowf = __expf(fminf(ci_ - cref8[ks], 80.f));
#pragma unroll
          for (int e = 0; e < 8; ++e) {
            const int j = ks * 16 + 8 * h + e;
            const bool ok = dir ? (j >= i) : (j <= i);
            f[e] = ok ? f[e] * rowf * dtv[j] : 0.f;
          }
        } else {
#pragma unroll
          for (int e = 0; e < 8; ++e) {
            const int j = ks * 16 + 8 * h + e;
            const bool ok = dir ? (j >= i) : (j <= i);
            f[e] = ok ? f[e] * __expf(fminf(ci_ - cum[j], 0.f)) * dtr[j] : 0.f;
          }
        }
        const bf16x8 af = __builtin_bit_cast(bf16x8, pack8(f));
#pragma unroll
        for (int nt = 0; nt < 2; ++nt) {
          const bf16x8 bfv = *(const bf16x8*)(sXT + (32 * nt + c) * 136 + ks * 16 + 8 * h);
          Y1[nt] = MFMA(af, bfv, Y1[nt]);
        }
      }
    }
#pragma unroll
    for (int nt = 0; nt < 2; ++nt)
#pragma unroll
      for (int r = 0; r < 16; ++r) {
        const int ir = 32 * w + crow(r, h), pc = 32 * nt + c;
        const float y = Y1[nt][r] + Dk * bf2f(sXT[pc * 136 + ir]);
        Y[(size_t)(t0 + ir) * LDA + head * 64 + pc] = f2bf(y);
      }
#pragma unroll
    for (int mt = 0; mt < 2; ++mt)
#pragma unroll
      for (int r = 0; r < 16; ++r) S[mt][r] *= dec;
#pragma unroll
    for (int ks = 0; ks < 8; ++ks) {
#pragma unroll
      for (int mt = 0; mt < 2; ++mt) {
        const bf16x8 af = *(const bf16x8*)(sXS + (32 * mt + c) * 136 + ks * 16 + 8 * h);
        S[mt] = MFMA(af, btf[ks], S[mt]);
      }
    }
    __syncthreads();
#pragma unroll
    for (int mt = 0; mt < 2; ++mt)
#pragma unroll
      for (int r = 0; r < 16; ++r) sHS[(32 * mt + crow(r, h)) * 136 + 32 * w + c] = f2bf(S[mt][r]);
  }
  if (!lat) {
    float* o = OUTP(p) + (dir ? O_SB : O_SF) + ((size_t)((sidx * 4 + l) * 16 + head) * 64) * 128;
#pragma unroll
    for (int mt = 0; mt < 2; ++mt)
#pragma unroll
      for (int r = 0; r < 16; ++r) o[(size_t)(32 * mt + crow(r, h)) * 128 + 32 * w + c] = S[mt][r];
  }
  __syncthreads();
}

DI void attn_item(const Params& p, int l, int item) {
  const int tid = TID(), lane = tid & 63, w = __builtin_amdgcn_readfirstlane(tid >> 6), h = lane >> 5, c = lane & 31;
  int hh, t0, Lk, krow0, pos0; size_t vbase; bool lat;
  if (item < 1024) { const int b = item >> 8; hh = (item >> 5) & 7; const int qb = item & 31; lat = true; t0 = TC + b * 4096 + qb * 128; Lk = LKL; krow0 = b * LKL; vbase = (size_t)b * 512 * LKL; pos0 = qb * 128; }
  else { const int it = item - 1024; const int s = it >> 4; hh = (it >> 1) & 7; const int qb = it & 1; lat = false; t0 = s * 256 + qb * 128; Lk = 256; krow0 = KROW_CTX + s * 256; vbase = (size_t)4 * 512 * LKL + (size_t)s * 512 * 256; pos0 = 0; }
  const u16* Q = (const u16*)(WSP(p) + WS_Q); const u16* KN = (const u16*)(WSP(p) + WS_KN); const u16* KRA = (const u16*)(WSP(p) + WS_KR);
  const u16* VT = (const u16*)(WSP(p) + WS_VT) + vbase + (size_t)hh * 64 * Lk;
  u16* YC = (u16*)(WSP(p) + WS_YC);
  u16* sK = (u16*)smem;
  u16* sV = sK + 2 * 64 * 104;
  bf16x8 qf[6];
  {
    const int tq = t0 + 32 * w + c;
    const u16* qrow = Q + (size_t)tq * 768 + hh * 96 + 8 * h;
    float f[6][8];
#pragma unroll
    for (int s = 0; s < 6; ++s) unpack8(*(const u32x4*)(qrow + 16 * s), f[s]);
    if (lat) {
      const int pos = pos0 + 32 * w + c;
#pragma unroll
      for (int e = 0; e < 8; ++e) {
        const int ii = 8 * h + e;
        const float pp = (ii < 8) ? (float)(pos >> 6) : (float)(pos & 63);
        const float inv = exp2f(-(float)(ii & 7) * (13.287712379549449f / 8.f));
        const float ang = pp * inv;
        const float cs = cosf(ang), sn = sinf(ang);
        const float x1 = f[4][e], x2 = f[5][e];
        f[4][e] = x1 * cs - x2 * sn; f[5][e] = x1 * sn + x2 * cs;
      }
    }
    const float sc = 0.10206207261596575f * 1.4426950408889634f;
#pragma unroll
    for (int s = 0; s < 6; ++s) {
#pragma unroll
      for (int e = 0; e < 8; ++e) f[s][e] *= sc;
      qf[s] = __builtin_bit_cast(bf16x8, pack8(f[s]));
    }
  }
  f32x16 O[2];
#pragma unroll
  for (int vt = 0; vt < 2; ++vt)
#pragma unroll
    for (int r = 0; r < 16; ++r) O[vt][r] = 0.f;
  float m_run = -1e30f, l_run = 0.f;
  const int ntile = Lk >> 6;
  u32x4 rk[3], rv[2];
  auto gload = [&](int kt) {
    const int key0 = kt * 64;
#pragma unroll
    for (int q = 0; q < 3; ++q) {
      const int id = tid + 256 * q, key = id / 12, cc = id - key * 12;
      const size_t kr = (size_t)(krow0 + key0 + key);
      rk[q] = cc < 8 ? *(const u32x4*)(KN + kr * 512 + hh * 64 + cc * 8) : *(const u32x4*)(KRA + kr * 32 + (cc - 8) * 8);
    }
#pragma unroll
    for (int q = 0; q < 2; ++q) {
      const int id = tid + 256 * q, v = id >> 3, cc = id & 7;
      rv[q] = *(const u32x4*)(VT + (size_t)v * Lk + key0 + cc * 8);
    }
  };
  auto sstore = [&](int buf) {
#pragma unroll
    for (int q = 0; q < 3; ++q) {
      const int id = tid + 256 * q, key = id / 12, cc = id - key * 12;
      *(u32x4*)(sK + buf * 64 * 104 + key * 104 + cc * 8) = rk[q];
    }
#pragma unroll
    for (int q = 0; q < 2; ++q) {
      const int id = tid + 256 * q, v = id >> 3, cc = id & 7;
      u16* d = sV + buf * 64 * 68 + v * 68 + cc * 8;
      u32x2 lo = {rv[q][0], rv[q][1]}, hi = {rv[q][2], rv[q][3]};
      *(u32x2*)d = lo; *(u32x2*)(d + 4) = hi;
    }
  };
  gload(0);
  __syncthreads();
  sstore(0);
  __syncthreads();
  for (int kt = 0; kt < ntile; ++kt) {
    const int cur = kt & 1;
    if (kt + 1 < ntile) gload(kt + 1);
    f32x16 Sx[2];
#pragma unroll
    for (int k2 = 0; k2 < 2; ++k2) {
#pragma unroll
      for (int r = 0; r < 16; ++r) Sx[k2][r] = 0.f;
      const u16* kp = sK + cur * 64 * 104 + (32 * k2 + c) * 104 + 8 * h;
#pragma unroll
      for (int s = 0; s < 6; ++s) Sx[k2] = MFMA(*(const bf16x8*)(kp + 16 * s), qf[s], Sx[k2]);
    }
    float mx = Sx[0][0];
#pragma unroll
    for (int k2 = 0; k2 < 2; ++k2)
#pragma unroll
      for (int r = 0; r < 16; ++r) mx = fmaxf(mx, Sx[k2][r]);
    mx = fmaxf(mx, __shfl_xor(mx, 32));
    const float m_new = fmaxf(m_run, mx);
    const float alpha = __builtin_amdgcn_exp2f(m_run - m_new);
    m_run = m_new;
    float ls = 0.f;
#pragma unroll
    for (int k2 = 0; k2 < 2; ++k2)
#pragma unroll
      for (int r = 0; r < 16; ++r) { const float pv = __builtin_amdgcn_exp2f(Sx[k2][r] - m_new); Sx[k2][r] = pv; ls += pv; }
    l_run = l_run * alpha + ls;
#pragma unroll
    for (int vt = 0; vt < 2; ++vt)
#pragma unroll
      for (int r = 0; r < 16; ++r) O[vt][r] *= alpha;
#pragma unroll
    for (int k2 = 0; k2 < 2; ++k2)
#pragma unroll
      for (int s2 = 0; s2 < 2; ++s2) {
        u32x4 pp;
        pp[0] = pk2(Sx[k2][8 * s2 + 0], Sx[k2][8 * s2 + 1]); pp[1] = pk2(Sx[k2][8 * s2 + 2], Sx[k2][8 * s2 + 3]);
        pp[2] = pk2(Sx[k2][8 * s2 + 4], Sx[k2][8 * s2 + 5]); pp[3] = pk2(Sx[k2][8 * s2 + 6], Sx[k2][8 * s2 + 7]);
        const bf16x8 pf = __builtin_bit_cast(bf16x8, pp);
#pragma unroll
        for (int vt = 0; vt < 2; ++vt) {
          const u16* vp = sV + cur * 64 * 68 + (32 * vt + c) * 68 + 32 * k2 + 16 * s2 + 4 * h;
          const u32x2 lo = *(const u32x2*)vp, hi = *(const u32x2*)(vp + 8);
          u32x4 vv = {lo[0], lo[1], hi[0], hi[1]};
          O[vt] = MFMA(__builtin_bit_cast(bf16x8, vv), pf, O[vt]);
        }
      }
    if (kt + 1 < ntile) sstore(cur ^ 1);
    __syncthreads();
  }
  const float lt = l_run + __shfl_xor(l_run, 32);
  const float invl = 1.f / lt;
  const int tq = t0 + 32 * w + c;
#pragma unroll
  for (int vt = 0; vt < 2; ++vt)
#pragma unroll
    for (int g = 0; g < 4; ++g) {
      u32x2 pk; pk[0] = pk2(O[vt][4 * g] * invl, O[vt][4 * g + 1] * invl); pk[1] = pk2(O[vt][4 * g + 2] * invl, O[vt][4 * g + 3] * invl);
      *(u32x2*)(YC + (size_t)tq * 512 + hh * 64 + 32 * vt + 8 * g + 4 * h) = pk;
    }
}

DI void l5_phase(const Params& p, int l, int rep = 0) {
  u32* ctr = (u32*)(WSP(p) + WS_CTR) + l + 8 * rep;
  int* sitem = (int*)(smem + 73728 - 16);
  constexpr int NITEMS = 128 + 1024 + 256 + 512;
  while (true) {
    __syncthreads();
    if (TID() == 0) *sitem = (int)atomicAdd(ctr, 1u);
    __syncthreads();
    const int it = *sitem;
    if (it >= NITEMS) break;
    if (it < 128) ssd_unit(p, l, it);
    else if (it < 128 + 1280) attn_item(p, l, it - 128);
    else ssd_unit(p, l, it - 1280);
  }
}

DI void l5b_phase(const Params& p, int l) {
  u16* ACT = (u16*)(WSP(p) + WS_ACT);
  float* RB = (float*)(WSP(p) + WS_RB);
  const int lane = TID() & 63, gw = BID() * 4 + (TID() >> 6), nwv = gridDim.x * 4;
  for (int t = gw; t < T; t += nwv) {
    u16* row = ACT + (size_t)t * LDA;
    float ss = 0.f;
#pragma unroll
    for (int q = 0; q < 2; ++q) {
      const int c8 = (lane + 64 * q) * 8;
      float yf[8], yb[8], z[8], o[8];
      unpack8(*(const u32x4*)(row + C_YF + c8), yf); unpack8(*(const u32x4*)(row + C_YB + c8), yb); unpack8(*(const u32x4*)(row + C_Z + c8), z);
#pragma unroll
      for (int e = 0; e < 8; ++e) { o[e] = (yf[e] + yb[e]) * silu_f(z[e]); ss += o[e] * o[e]; }
      *(u32x4*)(row + C_YF + c8) = pack8(o);
    }
    ss = wave_sum(ss);
    if (lane == 0) RB[t] = rsqrtf(ss * (1.f / 1024.f) + EPS);
  }
}

DI int gate_col(int n) { return n < 2048 ? n : 3584 + (n - 2048); }
DI void l6a_phase(const Params& p, int l, int& nbar) {
  constexpr int NT = 24, MT = 80;
  TILE_LOOP(MT * NT) {
    group_sync(p, nbar);
    if (idx >= MT * NT) continue;
    int mt, nt; decode_tile(idx, NT, mt, nt);
    const u16* W = (const u16*)(WSP(p) + WS_W) + W_GATE;
    const u16* H = (const u16*)(WSP(p) + WS_H);
    u16* ACT = (u16*)(WSP(p) + WS_ACT);
    f32x16 acc[8];
#pragma unroll
    for (int j = 0; j < 8; ++j)
#pragma unroll
      for (int r = 0; r < 16; ++r) acc[j][r] = 0.f;
    gemm_tile_wf8(W, 1024, nt * 128, H + (size_t)mt * 256 * 1024, 1024, acc);
    const int m0 = mt * 256, gc0 = gate_col(nt * 128);
    stage_bf16_w8([&](int j, int r) { return sigmoid_f(acc[j][r]); });
    copy_out_bf16_256x128(ACT + (size_t)m0 * LDA + gc0, LDA, 128);
  }
}
DI void l6b_phase(const Params& p, int l, int& nbar) {
  TILE_LOOP(160 * 8) {
    group_sync(p, nbar);
    if (idx >= 160 * 8) continue;
    int mt, nt; decode_tile(idx, 8, mt, nt);
    const int m0 = mt * 128, n0 = nt * 128;
    u32 Mp[2][2][8];
#pragma unroll
    for (int i = 0; i < 2; ++i)
#pragma unroll
      for (int j = 0; j < 2; ++j)
#pragma unroll
        for (int r = 0; r < 8; ++r) Mp[i][j][r] = 0u;
#pragma unroll 1
    for (int br = 0; br < 3; ++br) {
      const u16* W = (const u16*)(WSP(p) + WS_W);
      const u16* ACT = (const u16*)(WSP(p) + WS_ACT);
      f32x16 acc[2][2]; zero_acc(acc);
      const u16* Ab; const u16* Wb; int ldab, Kb;
      if (br == 0) { Ab = (const u16*)(WSP(p) + WS_YA) + (size_t)m0 * 512; ldab = 512; Wb = W + W_A + (size_t)n0 * 512; Kb = 512; }
      else if (br == 1) { Ab = ACT + (size_t)m0 * LDA + C_YF; ldab = LDA; Wb = W + W_B + (size_t)n0 * 1024; Kb = 1024; }
      else { Ab = (const u16*)(WSP(p) + WS_YC) + (size_t)m0 * 512; ldab = 512; Wb = W + W_C + (size_t)n0 * 512; Kb = 512; }
      gemm_tile(Wb, Kb, Ab, ldab, Kb, acc);
      const float* RB = (const float*)(WSP(p) + WS_RB);
      const int tid3 = TID(), lane3 = tid3 & 63, w3 = tid3 >> 6;
      const int wm = w3 >> 1, h = lane3 >> 5, wn = w3 & 1, c = lane3 & 31;
      const int gc0 = gate_col(br * 1024 + n0);
      u16* sG = (u16*)smem;
#pragma unroll
      for (int q = 0; q < 8; ++q) {
        const int id = tid3 + 256 * q, row = id >> 4, cc = id & 15;
        *(u32x4*)(sG + row * 136 + cc * 8) = *(const u32x4*)(ACT + (size_t)(m0 + row) * LDA + gc0 + cc * 8);
      }
      __syncthreads();
#pragma unroll
      for (int j = 0; j < 2; ++j) {
        const int ml = wn * 64 + j * 32 + c;
        const float rb = (br == 1) ? RB[m0 + ml] : 1.f;
#pragma unroll
        for (int i = 0; i < 2; ++i)
#pragma unroll
          for (int g = 0; g < 4; ++g) {
            const u32x2 gv = *(const u32x2*)(sG + ml * 136 + wm * 64 + i * 32 + 8 * g + 4 * h);
            const float v0 = acc[i][j][4 * g] * rb, v1 = acc[i][j][4 * g + 1] * rb, v2 = acc[i][j][4 * g + 2] * rb, v3 = acc[i][j][4 * g + 3] * rb;
            Mp[i][j][2 * g] = pk2(bflo(Mp[i][j][2 * g]) + bflo(gv[0]) * v0, bfhi(Mp[i][j][2 * g]) + bfhi(gv[0]) * v1);
            Mp[i][j][2 * g + 1] = pk2(bflo(Mp[i][j][2 * g + 1]) + bflo(gv[1]) * v2, bfhi(Mp[i][j][2 * g + 1]) + bfhi(gv[1]) * v3);
          }
      }
    }
    {
      u16* MG = (u16*)(WSP(p) + WS_XT);
      u16* sC = (u16*)smem;
      const int tid4 = TID(), lane4 = tid4 & 63, w4 = tid4 >> 6;
      const int wm = w4 >> 1, h = lane4 >> 5, wn = w4 & 1, c = lane4 & 31;
      __syncthreads();
#pragma unroll
      for (int i = 0; i < 2; ++i)
#pragma unroll
        for (int j = 0; j < 2; ++j)
#pragma unroll
          for (int g = 0; g < 4; ++g) {
            u32x2 pk; pk[0] = Mp[i][j][2 * g]; pk[1] = Mp[i][j][2 * g + 1];
            *(u32x2*)(sC + (wn * 64 + j * 32 + c) * 136 + wm * 64 + i * 32 + 8 * g + 4 * h) = pk;
          }
      __syncthreads();
      copy_out_bf16<128>(MG + (size_t)m0 * 1024 + n0, 1024, 128);
    }
  }
}

DI void resid_gemm_phase(const Params& p, int l, const u16* A, int lda, const u16* Wm, int K, int gidx, int& nbar) {
  float* X = OUTP(p);
  const float* MOD = (const float*)(WSP(p) + WS_MOD) + (size_t)l * 5 * 6144 + gidx * 1024;
  constexpr int NFULL = 1024, NITEM = 1024 + 512;
  TILE_LOOP(NITEM) {
    group_sync(p, nbar);
    if (idx >= NITEM) continue;
    const bool halfm = idx >= NFULL;
    const int tile = halfm ? NFULL + ((idx - NFULL) >> 1) : idx;
    int mt, nt; decode_tile(tile, 8, mt, nt);
    const int m0 = mt * 128 + (halfm ? ((idx - NFULL) & 1) * 64 : 0), n0 = nt * 128;
    const float* gt = MOD + tile_cb(mt) * 6144 + n0;
    float* sC = (float*)smem;
    const int tid = TID(), lane = tid & 63, w = tid >> 6, h = lane >> 5, c = lane & 31, cc = tid & 31;
    if (!halfm) {
      f32x16 acc[4];
#pragma unroll
      for (int j = 0; j < 4; ++j)
#pragma unroll
        for (int r = 0; r < 16; ++r) acc[j][r] = 0.f;
      gemm_tile_wf4(Wm, K, n0, A + (size_t)m0 * lda, lda, acc);
      stage_f32_w4(acc);
    } else {
      f32x16 acc[2];
#pragma unroll
      for (int j = 0; j < 2; ++j)
#pragma unroll
        for (int r = 0; r < 16; ++r) acc[j][r] = 0.f;
      gemm_tile_wf2(Wm, K, n0, A + (size_t)m0 * lda, lda, acc);
#pragma unroll
      for (int j = 0; j < 2; ++j)
#pragma unroll
        for (int g = 0; g < 4; ++g) {
          f4 v; v[0] = acc[j][4 * g]; v[1] = acc[j][4 * g + 1]; v[2] = acc[j][4 * g + 2]; v[3] = acc[j][4 * g + 3];
          *(f4*)(sC + (j * 32 + c) * 132 + w * 32 + 8 * g + 4 * h) = v;
        }
      __syncthreads();
    }
    {
      const f4 g4 = *(const f4*)(gt + cc * 4);
      const int nq = halfm ? 8 : 16;
#pragma unroll 4
      for (int q = 0; q < nq; ++q) {
        const int row = (tid >> 5) + 8 * q;
        const f4 v = *(const f4*)(sC + row * 132 + cc * 4);
        float* xp = X + (size_t)(m0 + row) * 1024 + n0 + cc * 4;
        f4 x = *(const f4*)xp; x[0] += g4[0] * v[0]; x[1] += g4[1] * v[1]; x[2] += g4[2] * v[2]; x[3] += g4[3] * v[3]; *(f4*)xp = x;
      }
    }
  }
}

template <int MODE = 0>
DI void l9_phase(const Params& p, int l, int& nbar) {
  const u16* W = (const u16*)(WSP(p) + WS_W) + W_F13;
  const u16* H = (const u16*)(WSP(p) + WS_H);
  u16* ACT = (u16*)(WSP(p) + WS_ACT);
  constexpr int NT = 44, MT = 80;
  TILE_LOOP(MT * NT) {
    group_sync(p, nbar);
    if (idx >= MT * NT) continue;
    int mt, nt; decode_tile(idx, NT, mt, nt);
    f32x16 acc[8];
#pragma unroll
    for (int j = 0; j < 8; ++j)
#pragma unroll
      for (int r = 0; r < 16; ++r) acc[j][r] = 0.f;
    gemm_tile_wf8(W, 1024, nt * 128, H + (size_t)mt * 256 * 1024, 1024, acc);
    stage_bf16_w8u([&](int j, int r) { return silu_f(acc[j][r]) * acc[j][r + 8]; });
    if (MODE == 0) copy_out_bf16_256x64(ACT + (size_t)mt * 256 * LDA + C_U + nt * 64, LDA);
  }
}

DI void final_phase(const Params& p) {
  float* X = OUTP(p);
  const float* nw = INP(p, I_FNW);
  const int lane = TID() & 63, gw = BID() * 4 + (TID() >> 6), nwv = gridDim.x * 4;
  for (int t = gw; t < T; t += nwv) {
    f4* xr = (f4*)(X + (size_t)t * 1024) + lane;
    f4 v[4]; float s = 0.f;
#pragma unroll
    for (int j = 0; j < 4; ++j) { v[j] = xr[64 * j]; s += v[j][0] * v[j][0] + v[j][1] * v[j][1] + v[j][2] * v[j][2] + v[j][3] * v[j][3]; }
    const float rstd = rsqrtf(wave_sum(s) * (1.f / 1024.f) + EPS);
#pragma unroll
    for (int j = 0; j < 4; ++j) {
      const f4 wv = *(const f4*)(nw + 4 * lane + 256 * j);
      f4 o; o[0] = v[j][0] * rstd * wv[0]; o[1] = v[j][1] * rstd * wv[1]; o[2] = v[j][2] * rstd * wv[2]; o[3] = v[j][3] * rstd * wv[3];
      xr[64 * j] = o;
    }
  }
}

constexpr int NPH_LAYER = 11;
constexpr int NPHASE = 1 + NLAYER * NPH_LAYER + 1;

DI void run_phase(const Params& p, int ph) {
  int nbar = 0;
  if (ph == 0) { pre_phase(p); return; }
  if (ph == NPHASE - 1) { final_phase(p); return; }
  const int l = (ph - 1) / NPH_LAYER, s = (ph - 1) % NPH_LAYER;
  const u16* W = (const u16*)(WSP(p) + WS_W);
  const u16* ACT = (const u16*)(WSP(p) + WS_ACT);
  switch (s) {
    case 0: l1_phase(p, l); break;
    case 1: l2_phase(p, l, nbar); break;
    case 2: l3_phase(p, l); break;
    case 3: l4_phase(p, l, nbar); break;
    case 4: l5_phase(p, l); break;
    case 5: l5b_phase(p, l); break;
    case 6: l6a_phase(p, l, nbar); l6b_phase(p, l, nbar); break;
    case 7: resid_gemm_phase(p, l, (const u16*)(WSP(p) + WS_XT), 1024, W + W_O, 1024, 2, nbar); break;
    case 8: norm_phase(p, l, 1); break;
    case 9: l9_phase(p, l, nbar); break;
    case 10: resid_gemm_phase(p, l, ACT + C_U, LDA, W + W_F2, FF, 5, nbar); break;
  }
}

__global__ void __launch_bounds__(256, 2) fwd_kernel(Params p) {
#if MULTI
  run_phase(p, p.ph_lo);
#else
  cg::grid_group grid = cg::this_grid();
  if (threadIdx.x == 0) xb_words = make_uint4(0u, 0u, 0u, 0u);
  __syncthreads();
  if (threadIdx.x == 0) (void)xb_add(&((unsigned*)(WSP(p) + WS_BAR))[XB_XCNT(xb_xcc_id())], 1u);
  if (p.ph_lo < 0) grid.sync();
  int nbar = 0;
  pre_phase(p); gsync(p);
#pragma unroll 1
  for (int l = 0; l < NLAYER; ++l) {
    l1_phase(p, l); gsync(p);
    if (PROBE_DUP == 1) { l1_phase(p, l); gsync(p); }
    l2_phase(p, l, nbar); gsync(p);
    if (PROBE_DUP == 2) { l2_phase(p, l, nbar); gsync(p); }
    l3_phase(p, l); l3d_phase(p, l); gsync(p);
    if (PROBE_DUP == 3) { l3_phase(p, l); gsync(p); }
    l4_phase(p, l, nbar); gsync(p);
    if (PROBE_DUP == 4) { l4_phase(p, l, nbar); gsync(p); }
    l5_phase(p, l); gsync(p);
    if (PROBE_DUP == 5) { l5_phase(p, l, 1); gsync(p); }
    l5b_phase(p, l); gsync(p);
    l6a_phase(p, l, nbar); gsync(p);
    l6b_phase(p, l, nbar); gsync(p);
    resid_gemm_phase(p, l, (const u16*)(WSP(p) + WS_XT), 1024, (const u16*)(WSP(p) + WS_W) + W_O, 1024, 2, nbar); gsync(p);
    norm_phase(p, l, 1); gsync(p);
    l9_phase(p, l, nbar); gsync(p);
    if (PROBE_DUP == 9) { l9_phase<GEMM_MODE_PROBE>(p, l, nbar); gsync(p); }
    resid_gemm_phase(p, l, (const u16*)(WSP(p) + WS_ACT) + C_U, LDA, (const u16*)(WSP(p) + WS_W) + W_F2, FF, 5, nbar); gsync(p);
  }
  final_phase(p);
#endif
}

extern "C" void kernel_launch(void* const* d_in, const int* in_sizes, int n_in, void* d_out, int out_size, void* d_ws, size_t ws_size,
                              hipStream_t stream) {
  static int grid_blocks = 0;
  if (!grid_blocks) {
    int dev = 0, cus = 0, per_cu = 0;
    hipGetDevice(&dev);
    hipDeviceGetAttribute(&cus, hipDeviceAttributeMultiprocessorCount, dev);
    hipOccupancyMaxActiveBlocksPerMultiprocessor(&per_cu, fwd_kernel, 256, 0);
    per_cu = 2;
    grid_blocks = cus * per_cu;
    if (ws_size < WS_END || n_in != 32) { fprintf(stderr, "kernel_launch: ws too small (%zu < %zu) or n_in %d\n", ws_size, (size_t)WS_END, n_in); grid_blocks = -1; }
  }
  if (grid_blocks < 0) return;
  Params p{};
  for (int i = 0; i < 32; ++i) p.in[i] = (const float*)d_in[i];
  p.in[32] = (const float*)d_out;
  p.in[33] = (const float*)d_ws;
#if MULTI
  for (int ph = 0; ph < NPHASE; ++ph) {
    p.ph_lo = ph; p.ph_hi = ph + 1;
    hipLaunchKernelGGL(fwd_kernel, dim3(grid_blocks), dim3(256), 0, stream, p);
  }
#else
  p.ph_lo = 0; p.ph_hi = NPHASE;
  (void)hipMemsetAsync((char*)d_ws + WS_BAR, 0, 16384, stream);
  void* args[] = {&p};
  hipError_t e = hipLaunchCooperativeKernel((void*)fwd_kernel, dim3(grid_blocks), dim3(256), args, 0, stream);
  if (e != hipSuccess) fprintf(stderr, "cooperative launch failed: %s (grid %d)\n", hipGetErrorString(e), grid_blocks);
#endif
}
```
